# Optimizing an MI355X kernel written in HIP

```python
import math
import jax, jax.numpy as jnp
from jax import lax
import numpy as np

D_MODEL = 2048
BATCH = 4
SEQ = 4096
DEPTH = 2

GRID_W = 64
CTX_LEN = 256
N_EVEN = (DEPTH + 1) // 2
N_ODD = DEPTH // 2
HEAD_DIM = 128
NA_HEADS = D_MODEL // (2 * HEAD_DIM)
NA_WIN_H = 8
NA_WIN_W = 16
DIFF_HEAD_DIM = 128
DIFF_HEADS = D_MODEL // (4 * DIFF_HEAD_DIM)
NA_WIDTH = NA_HEADS * HEAD_DIM
DIFF_WIDTH = DIFF_HEADS * 2 * DIFF_HEAD_DIM
EVEN_PROJ = 3 * NA_WIDTH + 3 * DIFF_WIDTH
MLA_HEADS = D_MODEL // 128
MLA_Q_RANK = 512
MLA_KV_RANK = 512
MLA_NOPE = 128
MLA_ROPE = 64
MLA_V = 128
MLA_DOWN = MLA_Q_RANK + MLA_KV_RANK + MLA_ROPE
D_FF = 128 * ((8 * D_MODEL // 3 + 127) // 128)
CONV_W = 3
Q_BLOCK = 128
ROPE_BASE = 10000.0
EPS = 1e-6

kernel_name = 'hybrid_na_diff_mla_dit_block'


def rms_norm(x, g):
    xf = x.astype(jnp.float32)
    y = xf * lax.rsqrt(jnp.mean(xf * xf, axis=-1, keepdims=True) + EPS)
    return (y * g.astype(jnp.float32)).astype(x.dtype)


def modulate(x, g, shift, scale):
    return rms_norm(x, g) * (1 + scale) + shift


def softmax32(s):
    return jax.nn.softmax(s.astype(jnp.float32), axis=-1)


def rope_1d(x, pos):
    half = x.shape[-1] // 2
    freqs = ROPE_BASE ** (-jnp.arange(half, dtype=jnp.float32) / half)
    ang = pos.astype(jnp.float32)[:, None] * freqs[None, :]
    cos = jnp.concatenate([jnp.cos(ang), jnp.cos(ang)], -1)[None, :, None, :].astype(x.dtype)
    sin = jnp.concatenate([jnp.sin(ang), jnp.sin(ang)], -1)[None, :, None, :].astype(x.dtype)
    rot = jnp.concatenate([-x[..., half:], x[..., :half]], -1)
    return x * cos + rot * sin


def rope_2d(x):
    L = x.shape[1]
    t = jnp.arange(L, dtype=jnp.int32)
    h = x.shape[-1] // 2
    return jnp.concatenate([rope_1d(x[..., :h], t // GRID_W), rope_1d(x[..., h:], t % GRID_W)], -1)


def map_query_blocks(fn, *qs):
    B, L = qs[0].shape[:2]
    nb = L // Q_BLOCK
    xs = tuple(jnp.moveaxis(q.reshape((B, nb, Q_BLOCK) + q.shape[2:]), 1, 0) for q in qs)
    out = lax.map(lambda a: fn(*a), xs)
    out = jnp.moveaxis(out, 0, 1)
    return out.reshape((B, L) + out.shape[3:])


def sdpa(q, k, v):
    s = jnp.einsum('bqhd,bkhd->bhqk', q, k) * (q.shape[-1] ** -0.5)
    return jnp.einsum('bhqk,bkhd->bqhd', softmax32(s).astype(v.dtype), v)


def diff_attend(q1, q2, k1, k2, v, lam):
    scale = q1.shape[-1] ** -0.5
    p1 = softmax32(jnp.einsum('bqhd,bkhd->bhqk', q1, k1) * scale)
    p2 = softmax32(jnp.einsum('bqhd,bkhd->bhqk', q2, k2) * scale)
    p = (p1 - lam * p2).astype(v.dtype)
    return jnp.einsum('bhqk,bkhd->bqhd', p, v)


def neighbourhood_attention(q, k, v, kc, vc, rpb):
    B, L, H, d = q.shape
    rows = L // GRID_W
    wh = min(NA_WIN_H, rows)
    ww = NA_WIN_W
    nk = wh * ww
    scale = d ** -0.5
    r = jnp.arange(rows, dtype=jnp.int32)
    key_rows = jnp.clip(r - wh // 2, 0, rows - wh)[:, None] + jnp.arange(wh, dtype=jnp.int32)[None, :]
    cidx = jnp.arange(GRID_W, dtype=jnp.int32)
    key_cols = jnp.clip(cidx - ww // 2, 0, GRID_W - ww)[:, None] + jnp.arange(ww, dtype=jnp.int32)[None, :]
    dc = key_cols - cidx[:, None] + (NA_WIN_W - 1)
    q_rows = jnp.moveaxis(q.reshape(B, rows, GRID_W, H, d), 1, 0)

    def row_block(args):
        q_r, kr, ri = args
        idx = (kr[None, :, None] * GRID_W + key_cols[:, None, :]).reshape(GRID_W, nk)
        kg = k[:, idx]
        vg = v[:, idx]
        dr = (kr - ri + (NA_WIN_H - 1))[None, :, None]
        bias = rpb[:, dr, dc[:, None, :]].reshape(H, GRID_W, nk)
        s_win = jnp.einsum('bqhd,bqkhd->bhqk', q_r, kg) * scale + bias[None]
        s_ctx = jnp.einsum('bqhd,bkhd->bhqk', q_r, kc) * scale
        p = softmax32(jnp.concatenate([s_win, s_ctx], -1)).astype(v.dtype)
        return (jnp.einsum('bhqk,bqkhd->bqhd', p[..., :nk], vg)
                + jnp.einsum('bhqk,bkhd->bqhd', p[..., nk:], vc))

    out = lax.map(row_block, (q_rows, key_rows, r))
    return jnp.moveaxis(out, 0, 1).reshape(B, L, H, d)


def even_mixer(h, hc, w_in, w_out, qn_a, kn_a, rpb, qn_b, kn_b, diff_lam, subln_b, lam_init, with_ctx):
    def project(t):
        B, L, _ = t.shape
        qa, ka, va, qb, kb, vb = jnp.split(
            t @ w_in, [NA_WIDTH, 2 * NA_WIDTH, 3 * NA_WIDTH, 3 * NA_WIDTH + DIFF_WIDTH, 3 * NA_WIDTH + 2 * DIFF_WIDTH], axis=-1)
        qa = rms_norm(qa.reshape(B, L, NA_HEADS, HEAD_DIM), qn_a)
        ka = rms_norm(ka.reshape(B, L, NA_HEADS, HEAD_DIM), kn_a)
        va = va.reshape(B, L, NA_HEADS, HEAD_DIM)
        qb = rms_norm(qb.reshape(B, L, 2 * DIFF_HEADS, DIFF_HEAD_DIM), qn_b)
        kb = rms_norm(kb.reshape(B, L, 2 * DIFF_HEADS, DIFF_HEAD_DIM), kn_b)
        vb = vb.reshape(B, L, DIFF_HEADS, 2 * DIFF_HEAD_DIM)
        return qa, ka, va, qb, kb, vb

    def halves(t):
        t = t.reshape(t.shape[0], t.shape[1], DIFF_HEADS, 2, DIFF_HEAD_DIM)
        return t[:, :, :, 0], t[:, :, :, 1]

    def merge(oa, ob):
        ob = rms_norm(ob, subln_b) * (1 - lam_init)
        o = jnp.concatenate([oa.reshape(oa.shape[0], oa.shape[1], -1), ob.reshape(ob.shape[0], ob.shape[1], -1)], -1)
        return o @ w_out

    qa, ka, va, qb, kb, vb = project(h)
    qa_c, ka_c, va_c, qb_c, kb_c, vb_c = project(hc)
    qb = rope_2d(qb)
    kb = rope_2d(kb)
    lf = diff_lam.astype(jnp.float32)
    lam = jnp.exp(jnp.sum(lf[0] * lf[1])) - jnp.exp(jnp.sum(lf[2] * lf[3])) + lam_init

    oa = neighbourhood_attention(qa, ka, va, ka_c, va_c, rpb)
    k1, k2 = halves(jnp.concatenate([kb, kb_c], 1))
    v_all = jnp.concatenate([vb, vb_c], 1)
    q1, q2 = halves(qb)
    ob = map_query_blocks(lambda a1, a2: diff_attend(a1, a2, k1, k2, v_all, lam), q1, q2)
    y = merge(oa, ob)
    yc = None
    if with_ctx:
        q1c, q2c = halves(qb_c)
        k1c, k2c = halves(kb_c)
        yc = merge(sdpa(qa_c, ka_c, va_c), diff_attend(q1c, q2c, k1c, k2c, vb_c, lam))
    return y, yc


def odd_mixer(h, hc, w_down, q_a_norm, kv_a_norm, w_uq, w_ukv, qn_nope, qn_rope, kn_nope, kn_rope, w_out, with_ctx):
    scale = (MLA_NOPE + MLA_ROPE) ** -0.5

    def queries(down, rotate):
        B, L, _ = down.shape
        q = (rms_norm(down[..., :MLA_Q_RANK], q_a_norm) @ w_uq).reshape(B, L, MLA_HEADS, MLA_NOPE + MLA_ROPE)
        q_nope = rms_norm(q[..., :MLA_NOPE], qn_nope)
        q_rope = rms_norm(q[..., MLA_NOPE:], qn_rope)
        if rotate:
            q_rope = rope_2d(q_rope)
        return q_nope, q_rope

    def keys_values(down, rotate):
        B, L, _ = down.shape
        kv = (rms_norm(down[..., MLA_Q_RANK:MLA_Q_RANK + MLA_KV_RANK], kv_a_norm) @ w_ukv).reshape(
            B, L, MLA_HEADS, MLA_NOPE + MLA_V)
        k_nope = rms_norm(kv[..., :MLA_NOPE], kn_nope)
        k_rope = rms_norm(down[:, :, None, MLA_Q_RANK + MLA_KV_RANK:], kn_rope)
        if rotate:
            k_rope = rope_2d(k_rope)
        return k_nope, k_rope[:, :, 0], kv[..., MLA_NOPE:]

    def attend(qn, qr, kn, kr, v):
        s = (jnp.einsum('bqhd,bkhd->bhqk', qn, kn) + jnp.einsum('bqhr,bkr->bhqk', qr, kr)) * scale
        return jnp.einsum('bhqk,bkhd->bqhd', softmax32(s).astype(v.dtype), v)

    down = h @ w_down
    down_c = hc @ w_down
    qn, qr = queries(down, True)
    kn, kr, v = keys_values(down, True)
    kn_c, kr_c, v_c = keys_values(down_c, False)
    kn_all = jnp.concatenate([kn, kn_c], 1)
    kr_all = jnp.concatenate([kr, kr_c], 1)
    v_all = jnp.concatenate([v, v_c], 1)
    o = map_query_blocks(lambda a, b: attend(a, b, kn_all, kr_all, v_all), qn, qr)
    y = o.reshape(o.shape[0], o.shape[1], -1) @ w_out
    yc = None
    if with_ctx:
        qn_c, qr_c = queries(down_c, False)
        oc = attend(qn_c, qr_c, kn_c, kr_c, v_c)
        yc = oc.reshape(oc.shape[0], oc.shape[1], -1) @ w_out
    return y, yc


def conv_ffn(h, w_in, conv_w, w_out):
    u = h @ w_in
    up = jnp.pad(u, ((0, 0), (1, 1), (0, 0)))
    u = up[:, :-2] * conv_w[0] + up[:, 1:-1] * conv_w[1] + up[:, 2:] * conv_w[2]
    a, b = jnp.split(u, 2, axis=-1)
    return (jax.nn.silu(a) * b) @ w_out


def setup_inputs(seed: int = 0) -> dict:
    key = jax.random.key(seed)
    ks = jax.random.split(key, 32)
    D = D_MODEL

    def nrm(k, shape, scale):
        return jax.random.normal(k, shape, jnp.float32) * scale

    def gain(k, shape):
        return 1.0 + 0.1 * jax.random.normal(k, shape, jnp.float32)

    return {
        'x': nrm(ks[0], (BATCH, SEQ, D), 1.0),
        'c': nrm(ks[1], (BATCH, D), 1.0),
        'ctx': nrm(ks[2], (BATCH, CTX_LEN, D), 1.0),
        'c_ctx': nrm(ks[3], (D,), 1.0),
        'ada_w': nrm(ks[4], (DEPTH, D, 6 * D), 0.5 * D ** -0.5),
        'ada_b': nrm(ks[5], (DEPTH, 6 * D), 0.02),
        'norm_mix': gain(ks[6], (DEPTH, D)),
        'norm_ffn': gain(ks[7], (DEPTH, D)),
        'ffn_w_in': nrm(ks[8], (DEPTH, D, 2 * D_FF), D ** -0.5),
        'ffn_conv': nrm(ks[9], (DEPTH, CONV_W, 2 * D_FF), CONV_W ** -0.5),
        'ffn_w_out': nrm(ks[10], (DEPTH, D_FF, D), D_FF ** -0.5),
        'even_w_in': nrm(ks[11], (N_EVEN, D, EVEN_PROJ), D ** -0.5),
        'even_w_out': nrm(ks[12], (N_EVEN, NA_WIDTH + DIFF_WIDTH, D), (NA_WIDTH + DIFF_WIDTH) ** -0.5),
        'na_q_norm': gain(ks[13], (N_EVEN, HEAD_DIM)),
        'na_k_norm': gain(ks[14], (N_EVEN, HEAD_DIM)),
        'na_rpb': nrm(ks[15], (N_EVEN, NA_HEADS, 2 * NA_WIN_H - 1, 2 * NA_WIN_W - 1), 0.5),
        'diff_q_norm': gain(ks[16], (N_EVEN, DIFF_HEAD_DIM)),
        'diff_k_norm': gain(ks[17], (N_EVEN, DIFF_HEAD_DIM)),
        'diff_lambda': nrm(ks[18], (N_EVEN, 4, DIFF_HEAD_DIM), 0.1),
        'diff_subln': gain(ks[19], (N_EVEN, 2 * DIFF_HEAD_DIM)),
        'mla_w_down': nrm(ks[20], (N_ODD, D, MLA_DOWN), D ** -0.5),
        'mla_q_a_norm': gain(ks[21], (N_ODD, MLA_Q_RANK)),
        'mla_kv_a_norm': gain(ks[22], (N_ODD, MLA_KV_RANK)),
        'mla_w_uq': nrm(ks[23], (N_ODD, MLA_Q_RANK, MLA_HEADS * (MLA_NOPE + MLA_ROPE)), MLA_Q_RANK ** -0.5),
        'mla_w_ukv': nrm(ks[24], (N_ODD, MLA_KV_RANK, MLA_HEADS * (MLA_NOPE + MLA_V)), MLA_KV_RANK ** -0.5),
        'mla_q_nope_norm': gain(ks[25], (N_ODD, MLA_NOPE)),
        'mla_q_rope_norm': gain(ks[26], (N_ODD, MLA_ROPE)),
        'mla_k_nope_norm': gain(ks[27], (N_ODD, MLA_NOPE)),
        'mla_k_rope_norm': gain(ks[28], (N_ODD, MLA_ROPE)),
        'mla_w_out': nrm(ks[29], (N_ODD, MLA_HEADS * MLA_V, D), (MLA_HEADS * MLA_V) ** -0.5),
    }


def reference(x, c, ctx, c_ctx, ada_w, ada_b, norm_mix, norm_ffn, ffn_w_in, ffn_conv, ffn_w_out,
              even_w_in, even_w_out, na_q_norm, na_k_norm, na_rpb, diff_q_norm, diff_k_norm,
              diff_lambda, diff_subln, mla_w_down, mla_q_a_norm, mla_kv_a_norm, mla_w_uq, mla_w_ukv,
              mla_q_nope_norm, mla_q_rope_norm, mla_k_nope_norm, mla_k_rope_norm, mla_w_out):
    xc = ctx
    s_lat = jax.nn.silu(c)
    s_ctx = jax.nn.silu(c_ctx)
    for l in range(DEPTH):
        with_ctx = l < DEPTH - 1
        mod = (s_lat @ ada_w[l] + ada_b[l])[:, None, :]
        mod_c = s_ctx @ ada_w[l] + ada_b[l]
        sh_m, sc_m, g_m, sh_f, sc_f, g_f = jnp.split(mod, 6, axis=-1)
        shc_m, scc_m, gc_m, shc_f, scc_f, gc_f = jnp.split(mod_c, 6, axis=-1)
        h = modulate(x, norm_mix[l], sh_m, sc_m)
        hc = modulate(xc, norm_mix[l], shc_m, scc_m)
        i = l // 2
        if l % 2 == 0:
            lam_init = 0.8 - 0.6 * math.exp(-0.3 * l)
            y, yc = even_mixer(h, hc, even_w_in[i], even_w_out[i], na_q_norm[i], na_k_norm[i], na_rpb[i],
                               diff_q_norm[i], diff_k_norm[i], diff_lambda[i], diff_subln[i], lam_init, with_ctx)
        else:
            y, yc = odd_mixer(h, hc, mla_w_down[i], mla_q_a_norm[i], mla_kv_a_norm[i], mla_w_uq[i], mla_w_ukv[i],
                              mla_q_nope_norm[i], mla_q_rope_norm[i], mla_k_nope_norm[i], mla_k_rope_norm[i],
                              mla_w_out[i], with_ctx)
        x = x + g_m * y
        x = x + g_f * conv_ffn(modulate(x, norm_ffn[l], sh_f, sc_f), ffn_w_in[l], ffn_conv[l], ffn_w_out[l])
        if with_ctx:
            xc = xc + gc_m * yc
            xc = xc + gc_f * conv_ffn(modulate(xc, norm_ffn[l], shc_f, scc_f), ffn_w_in[l], ffn_conv[l], ffn_w_out[l])
    return x
```

```cpp
#include <hip/hip_runtime.h>
#include <hip/hip_cooperative_groups.h>
#include <cstdio>
#include <cstdint>
namespace cg = cooperative_groups;
namespace pg8 {
#define PG8_LAS __attribute__((address_space(3)))
typedef unsigned short bf16_t;
typedef short bf16x8 __attribute__((ext_vector_type(8)));
typedef float f32x4 __attribute__((ext_vector_type(4)));
typedef unsigned u32x4 __attribute__((ext_vector_type(4)));
constexpr int BM = 256, BK = 64, HALF = 128, HTB = HALF * BK * 2  , STAGE_BYTES = 8 * HTB, NXCD = 8, WGM = 2;

__host__ __device__ __forceinline__ int lds_byte(int r, int c) { const int st = (r >> 4) * 2 + (c >> 5), rr = r & 15, cc = c & 31, ob = rr * 64 + cc * 2; return st * 1024 + (ob ^ (((ob >> 9) & 1) << 5)); }
__host__ __device__ __forceinline__ void stage_rc(int b, int& R, int& C) { const int st = b / 1024, sb = b % 1024, swz = sb ^ (((sb >> 9) & 1) << 5); R = (st >> 1) * 16 + swz / 64; C = (st & 1) * 32 + (swz % 64) / 2; }
__host__ __device__ __forceinline__ int perm32(int rho) { const int n = rho >> 4, i = rho & 15; return 8 * (i >> 2) + 4 * n + (i & 3); }

struct Unit { int pm, pn; int k0 = 0, nt = 0, ks = -1; };
struct Gemm { const bf16_t* A; const bf16_t* Bt; int M, N, K; int astep = 256; };

struct StaticOrder {
    int nM, nN, nwg, G, c;
    __host__ __device__ void init(int M, int N, int G_, int c_) { nM = M / BM; nN = N / BM; nwg = nM * nN; G = G_; c = c_; }
    __host__ __device__ bool next(int i, Unit& u) const {
        const long L = (long)i * G + c; if (L >= nwg) return false;
        int wgid = (int)L; { const int q = nwg / NXCD, r = nwg % NXCD, xcd = wgid % NXCD, off = wgid / NXCD; wgid = (xcd < r ? xcd * (q + 1) : r * (q + 1) + (xcd - r) * q) + off; }
        const int nig = WGM * nN, gid = wgid / nig, fm = gid * WGM, gsz = (nM - fm) < WGM ? (nM - fm) : WGM;
        u.pm = fm + ((wgid % nig) % gsz); u.pn = (wgid % nig) / gsz; return true;
    }
    __device__ __forceinline__ void a_ready(const Unit&) const {}
    __device__ __forceinline__ void done(const Unit&) const {}
};

__device__ __forceinline__ unsigned cvt_pk_bf16(float lo, float hi) { unsigned r; asm volatile("v_cvt_pk_bf16_f32 %0, %1, %2" : "=v"(r) : "v"(lo), "v"(hi)); return r; }
typedef float f32x2 __attribute__((ext_vector_type(2)));
__device__ __forceinline__ f32x2 gelu_pk(f32x2 v) {
    const f32x2 av = __builtin_elementwise_abs(v), d = av * 0.2316418882f + 1.0f;
    f32x2 t; t.x = __builtin_amdgcn_rcpf(d.x); t.y = __builtin_amdgcn_rcpf(d.y);
    f32x2 q = t * 0.5307027145f + (-0.7265760135f); q = q * t + 0.7107068705f; q = q * t + (-0.142248368f); q = q * t + 0.127414796f; q = q * t;
    const f32x2 s = (v * v) * (-0.72134752044f);
    f32x2 e; e.x = __builtin_amdgcn_exp2f(s.x); e.y = __builtin_amdgcn_exp2f(s.y);
    const f32x2 m = v * (q * e), r = v - m;
    f32x2 o; o.x = v.x < 0.f ? m.x : r.x; o.y = v.y < 0.f ? m.y : r.y; return o;
}

template <int ACT  > struct EpiBf16 {
    static constexpr bool PERM = true, AFTER_DRAIN = false; static_assert(ACT == 0 || ACT == 1, "EpiBf16: ACT is 0 (none) or 1 (gelu_pk)");
    bf16_t* O; int ldc; const float* bias; int split_cols; size_t split_stride; float scale0;
    __device__ __forceinline__ void operator()(const f32x4 (&acc)[2][2][4][2], const Unit& u, int wr, int wc, int fr, int fq) const {
        const int row0 = u.pm * BM + wr * 64 + fr; int colt = u.pn * BM; bf16_t* base = O;
        float sc = 1.f; if (split_cols) { const int t = colt / split_cols; base += (size_t)t * split_stride; colt -= t * split_cols; if (t == 0) sc = scale0; }
        const int col0 = colt + wc * 32 + 8 * fq, bcol0 = u.pn * BM + wc * 32 + 8 * fq;
        f32x4 bv[2][2];
#pragma unroll
        for (int bj = 0; bj < 2; ++bj)
#pragma unroll
            for (int n = 0; n < 2; ++n) bv[bj][n] = bias ? *(const f32x4*)(bias + bcol0 + bj * HALF + 4 * n) : (f32x4){0.f, 0.f, 0.f, 0.f};
#pragma unroll
        for (int ai = 0; ai < 2; ++ai)
#pragma unroll
            for (int m = 0; m < 4; ++m) { bf16_t* rowp = base + (size_t)(row0 + ai * HALF + m * 16) * ldc + col0;
#pragma unroll
                for (int bj = 0; bj < 2; ++bj) { f32x4 v0 = acc[ai][bj][m][0] + bv[bj][0], v1 = acc[ai][bj][m][1] + bv[bj][1];
                    if (ACT == 1) { f32x2 a = gelu_pk((f32x2){v0[0], v0[1]}), b = gelu_pk((f32x2){v0[2], v0[3]}), c = gelu_pk((f32x2){v1[0], v1[1]}), d = gelu_pk((f32x2){v1[2], v1[3]});
                        v0 = (f32x4){a.x, a.y, b.x, b.y}; v1 = (f32x4){c.x, c.y, d.x, d.y}; }
                    v0 = v0 * sc; v1 = v1 * sc; u32x4 w; w.x = cvt_pk_bf16(v0[0], v0[1]); w.y = cvt_pk_bf16(v0[2], v0[3]); w.z = cvt_pk_bf16(v1[0], v1[1]); w.w = cvt_pk_bf16(v1[2], v1[3]);
                    *(u32x4*)(rowp + bj * HALF) = w; } }
    }
};
template <class Epi, class Sched, bool ALIGN_EPI = false, bool SP2 = false>
__device__ __forceinline__ void gemm_phase(PG8_LAS unsigned char* lds, const Gemm g, const Sched& S, const Epi& E) {
    int tid_o = threadIdx.x; asm volatile("" : "+v"(tid_o)); const int tid = tid_o, wid = __builtin_amdgcn_readfirstlane(tid >> 6), lane = tid & 63, wr = wid >> 2, wc = wid & 3, fr = lane & 15, fq = lane >> 4;
    const int K = g.K, nt = K / BK;
    unsigned voffA[2], voffB[2];
#pragma unroll
    for (int i = 0; i < 2; ++i) { int R, C; stage_rc(tid * 16 + i * 8192, R, C); const int Rb = Epi::PERM ? ((R & ~31) + perm32(R & 31)) : R;
        voffA[i] = (unsigned)(R * K + C) * 2u; voffB[i] = (unsigned)(Rb * K + C) * 2u; }
    const size_t kstep = (size_t)(BK * 2);
    const size_t hstep = (size_t)HALF * K * 2;
    const size_t tstep = 2 * hstep;
    const unsigned ldsw = (unsigned)wid * 1024u;
    const int aoff = lds_byte(wr * 64 + fr, fq * 8), boff = lds_byte(wc * 32 + fr, fq * 8);
#define PG8_SA(b, h) (((b) * 2 + (h)) * HTB)
#define PG8_SB(b, h) ((4 + (b) * 2 + (h)) * HTB)
#define PG8_STAGE(bufoff, gbase, voff) do { _Pragma("unroll") for (int _i = 0; _i < 2; ++_i) \
        __builtin_amdgcn_global_load_lds((const unsigned*)((const char*)(gbase) + (voff)[_i]), (PG8_LAS unsigned*)(lds + (bufoff) + ldsw + _i * 8192), 16, 0, 0); } while (0)
#define PG8_LDA(dst, b, h) do { _Pragma("unroll") for (int m = 0; m < 4; ++m) _Pragma("unroll") for (int k = 0; k < 2; ++k) dst[m][k] = *(const PG8_LAS bf16x8*)(lds + PG8_SA(b, h) + aoff + m * 2048 + k * 1024); } while (0)
#define PG8_LDB(dst, b, h) do { _Pragma("unroll") for (int n = 0; n < 2; ++n) _Pragma("unroll") for (int k = 0; k < 2; ++k) dst[n][k] = *(const PG8_LAS bf16x8*)(lds + PG8_SB(b, h) + boff + n * 2048 + k * 1024); } while (0)
#define PG8_MMA(ai, bj, At, Bt) do { __builtin_amdgcn_s_setprio(1); _Pragma("unroll") for (int m = 0; m < 4; ++m) _Pragma("unroll") for (int n = 0; n < 2; ++n) _Pragma("unroll") for (int k = 0; k < 2; ++k) \
        acc[ai][bj][m][n] = __builtin_amdgcn_mfma_f32_16x16x32_bf16(Bt[n][k], At[m][k], acc[ai][bj][m][n], 0, 0, 0); __builtin_amdgcn_s_setprio(0); } while (0)
#define PG8_WAIT_V(n) asm volatile("s_waitcnt vmcnt(" #n ")" ::: "memory")
#define PG8_WAIT_L(n) asm volatile("s_waitcnt lgkmcnt(" #n ")" ::: "memory")
#define PG8_BAR __builtin_amdgcn_s_barrier()
#define PG8_SCHED __builtin_amdgcn_sched_barrier(0)
    Unit cur, nxt; int ui = 0;
    if (!S.next(0, cur)) return;
    f32x4 acc[2][2][4][2];
#pragma unroll
    for (int a = 0; a < 2; ++a)
#pragma unroll
        for (int b = 0; b < 2; ++b)
#pragma unroll
            for (int m = 0; m < 4; ++m)
#pragma unroll
                for (int n = 0; n < 2; ++n) acc[a][b][m][n] = (f32x4){0.f, 0.f, 0.f, 0.f};
    bf16x8 At[4][2], B0[2][2], B1[2][2];
    const size_t tstepA = (size_t)g.astep * K * 2; const char* cA = (const char*)g.A + (size_t)cur.pm * tstepA + (size_t)cur.k0 * kstep; const char* cB = (const char*)g.Bt + (size_t)cur.pn * tstep + (size_t)cur.k0 * kstep;
    S.a_ready(cur);
    if constexpr (SP2) {
        PG8_STAGE(PG8_SB(0, 0), cB, voffB); PG8_STAGE(PG8_SB(0, 1), cB + hstep, voffB); PG8_STAGE(PG8_SA(0, 0), cA, voffA); PG8_STAGE(PG8_SA(0, 1), cA + hstep, voffA);
        if (wr == 1) PG8_BAR;
        PG8_WAIT_V(2); PG8_BAR;
        PG8_STAGE(PG8_SB(1, 0), cB + kstep, voffB); PG8_STAGE(PG8_SA(1, 0), cA + kstep, voffA); PG8_STAGE(PG8_SB(1, 1), cB + hstep + kstep, voffB);
        PG8_WAIT_V(6); PG8_BAR;
    } else {
        PG8_STAGE(PG8_SB(0, 0), cB, voffB); PG8_STAGE(PG8_SA(0, 0), cA, voffA); PG8_STAGE(PG8_SB(0, 1), cB + hstep, voffB); PG8_STAGE(PG8_SA(0, 1), cA + hstep, voffA);
        if (wr == 1) PG8_BAR;
        PG8_WAIT_V(4); PG8_BAR;
        PG8_STAGE(PG8_SB(1, 0), cB + kstep, voffB); PG8_STAGE(PG8_SA(1, 0), cA + kstep, voffA); PG8_STAGE(PG8_SB(1, 1), cB + hstep + kstep, voffB);
        PG8_WAIT_V(6); PG8_BAR;
    }
    for (;;) {
        const bool has_next = S.next(ui + 1, nxt);
        const char* nA = has_next ? (const char*)g.A + (size_t)nxt.pm * tstepA + (size_t)nxt.k0 * kstep : cA; const char* nB = has_next ? (const char*)g.Bt + (size_t)nxt.pn * tstep + (size_t)nxt.k0 * kstep : cB;
        const int cnt = cur.nt ? cur.nt : nt;
        for (int t = 0; t < cnt; t += 2) {
            const bool last = (t == cnt - 2);
            const char* a1 = cA + (size_t)(t + 1) * kstep;
            const char* a2 = last ? nA : cA + (size_t)(t + 2) * kstep; const char* b2 = last ? nB : cB + (size_t)(t + 2) * kstep;
            const char* a3 = a2 + kstep; const char* b3 = b2 + kstep;
            if (last && has_next) S.a_ready(nxt);
            if constexpr (SP2) {
            PG8_LDB(B0, 0, 0); PG8_LDB(B1, 0, 1); PG8_SCHED; PG8_LDA(At, 0, 0); PG8_STAGE(PG8_SA(1, 1), a1 + hstep, voffA);
            PG8_WAIT_V(8); PG8_WAIT_L(0); PG8_BAR; PG8_MMA(0, 0, At, B0); PG8_MMA(0, 1, At, B1); PG8_BAR; PG8_SCHED;
            PG8_LDA(At, 0, 1); PG8_STAGE(PG8_SB(0, 0), b2, voffB); PG8_STAGE(PG8_SB(0, 1), b2 + hstep, voffB); PG8_STAGE(PG8_SA(0, 0), a2, voffA);
            PG8_WAIT_V(8); PG8_WAIT_L(0); PG8_BAR; PG8_MMA(1, 0, At, B0); PG8_MMA(1, 1, At, B1); PG8_BAR; PG8_SCHED;
            PG8_LDB(B0, 1, 0); PG8_LDB(B1, 1, 1); PG8_SCHED; PG8_LDA(At, 1, 0); PG8_STAGE(PG8_SA(0, 1), a2 + hstep, voffA);
            PG8_WAIT_V(8); PG8_WAIT_L(0); PG8_BAR; PG8_MMA(0, 0, At, B0); PG8_MMA(0, 1, At, B1); PG8_BAR; PG8_SCHED;
            PG8_LDA(At, 1, 1); PG8_STAGE(PG8_SB(1, 0), b3, voffB); PG8_STAGE(PG8_SB(1, 1), b3 + hstep, voffB); PG8_STAGE(PG8_SA(1, 0), a3, voffA);
            PG8_WAIT_V(8); PG8_WAIT_L(0); PG8_BAR; PG8_MMA(1, 0, At, B0); PG8_MMA(1, 1, At, B1); PG8_BAR; PG8_SCHED;
            } else {
            PG8_LDB(B0, 0, 0); PG8_SCHED; PG8_LDA(At, 0, 0); PG8_STAGE(PG8_SA(1, 1), a1 + hstep, voffA);
            PG8_WAIT_L(8); PG8_BAR; PG8_WAIT_L(0); PG8_MMA(0, 0, At, B0); PG8_BAR; PG8_SCHED;
            PG8_LDB(B1, 0, 1); PG8_STAGE(PG8_SB(0, 0), b2, voffB);
            PG8_BAR; PG8_WAIT_L(0); PG8_MMA(0, 1, At, B1); PG8_BAR;
            PG8_LDA(At, 0, 1); PG8_STAGE(PG8_SA(0, 0), a2, voffA);
            PG8_BAR; PG8_WAIT_L(0); PG8_MMA(1, 0, At, B0); PG8_BAR; PG8_SCHED;
            PG8_STAGE(PG8_SB(0, 1), b2 + hstep, voffB);
            PG8_WAIT_V(6); PG8_BAR; PG8_MMA(1, 1, At, B1); PG8_BAR;
            PG8_LDB(B0, 1, 0); PG8_SCHED; PG8_LDA(At, 1, 0); PG8_STAGE(PG8_SA(0, 1), a2 + hstep, voffA);
            PG8_WAIT_L(8); PG8_BAR; PG8_WAIT_L(0); PG8_MMA(0, 0, At, B0); PG8_BAR; PG8_SCHED;
            PG8_LDB(B1, 1, 1); PG8_STAGE(PG8_SB(1, 0), b3, voffB);
            PG8_BAR; PG8_WAIT_L(0); PG8_MMA(0, 1, At, B1); PG8_BAR;
            PG8_LDA(At, 1, 1); PG8_STAGE(PG8_SA(1, 0), a3, voffA);
            PG8_BAR; PG8_WAIT_L(0); PG8_MMA(1, 0, At, B0); PG8_BAR; PG8_SCHED;
            PG8_STAGE(PG8_SB(1, 1), b3 + hstep, voffB);
            PG8_WAIT_V(6); PG8_BAR; PG8_MMA(1, 1, At, B1); PG8_BAR;
            }
        }
        if constexpr (ALIGN_EPI) { if (wr == 0) PG8_BAR; }
        if constexpr (!Epi::AFTER_DRAIN) { E(acc, cur, wr, wc, fr, fq); S.done(cur); }
        if (!has_next) break;
#pragma unroll
        for (int a = 0; a < 2; ++a)
#pragma unroll
            for (int b = 0; b < 2; ++b)
#pragma unroll
                for (int m = 0; m < 4; ++m)
#pragma unroll
                    for (int n = 0; n < 2; ++n) acc[a][b][m][n] = (f32x4){0.f, 0.f, 0.f, 0.f};
        cur = nxt; cA = nA; cB = nB; ++ui;
        if constexpr (ALIGN_EPI) { if (wr == 1) PG8_BAR; }
    }
    PG8_WAIT_V(0);
    if constexpr (!ALIGN_EPI) { if (wr == 0) PG8_BAR; }
    PG8_BAR;
    if constexpr (Epi::AFTER_DRAIN) { E.fused(acc, cur, wr, wc, fr, fq, lds, wid, lane); S.done(cur); }
#undef PG8_SA
#undef PG8_SB
#undef PG8_STAGE
#undef PG8_LDA
#undef PG8_LDB
#undef PG8_MMA
#undef PG8_WAIT_V
#undef PG8_WAIT_L
#undef PG8_BAR
#undef PG8_SCHED
}
}

#ifndef PROBE
#define PROBE 0
#endif
#ifndef ONE_LAUNCH
#define ONE_LAUNCH 1
#endif
constexpr int DM = 2048, SEQ = 4096, NB = 4, CTXL = 256, NLAT = NB * SEQ, NCTX = NB * CTXL, NROW = NLAT + NCTX;
constexpr int EPROJ = 6144, DFF = 5504, DFF2 = 11008, MOD6 = 12288, DOWNP = 1280, QW = 3072, KVW = 4096;
constexpr int KSPLIT = 32;
constexpr float EPS = 1e-6f;
constexpr size_t MiB = 1u << 20;
constexpr size_t WS_MOD = 1 * MiB;
constexpr size_t WS_TAB128 = 1 * MiB + 512 * 1024, WS_TAB64 = WS_TAB128 + 64 * 32 * 8;
constexpr size_t WS_GAINS = 1 * MiB + 768 * 1024;
constexpr size_t WS_SSKV = 2 * MiB;
constexpr size_t WS_SSQ = 3 * MiB;
constexpr size_t WS_MODP = 2 * MiB;
constexpr size_t WS_XC = 18 * MiB;
constexpr size_t WS_WEIN = 26 * MiB;
constexpr size_t WS_WEOUT = 50 * MiB;
constexpr size_t WS_WFIN = 58 * MiB;
constexpr size_t WFIN_STRIDE = (size_t)DFF2 * DM * 2;
constexpr size_t WS_WFOUT = 144 * MiB;
constexpr size_t WFOUT_STRIDE = (size_t)DM * DFF * 2;
constexpr size_t WS_WDOWN = 187 * MiB;
constexpr size_t WS_WUQ = 192 * MiB;
constexpr size_t WS_WUKV = 195 * MiB;
constexpr size_t WS_WMOUT = 199 * MiB;
constexpr size_t WS_H = 208 * MiB + 4096;
constexpr size_t WS_R = 280 * MiB;
constexpr size_t WS_QKV = WS_R;
constexpr size_t WS_O = WS_R + 204 * MiB;
constexpr size_t WS_DIFFP = WS_R + 272 * MiB;
constexpr int UCH_T0 = 22, UCH_T1 = 21, ULD = UCH_T0 * 256;
constexpr size_t WS_U = WS_R;
constexpr size_t WS_ACT = WS_R;
constexpr size_t WS_PART = WS_R + 272 * MiB;
constexpr size_t WS_DOWN = WS_R;
constexpr size_t WS_QLAT = WS_R + 86 * MiB;
constexpr size_t WS_KVLAT = WS_R + 102 * MiB;
constexpr size_t WS_KROPE = WS_R + 120 * MiB;
constexpr size_t WS_Q1 = WS_R + 124 * MiB;
constexpr size_t WS_KV1 = WS_R + 220 * MiB;
constexpr size_t WS_O1 = WS_R + 356 * MiB;
constexpr size_t WS_XB = WS_R + 420 * MiB;
constexpr size_t WS_END = WS_R + 484 * MiB;

typedef unsigned short bf16_t;
typedef float f32x4 __attribute__((ext_vector_type(4)));
typedef short bf16x8 __attribute__((ext_vector_type(8)));
typedef short s16x4 __attribute__((ext_vector_type(4)));
typedef float f32x16 __attribute__((ext_vector_type(16)));
typedef unsigned u32x4 __attribute__((ext_vector_type(4)));
typedef unsigned u32x2 __attribute__((ext_vector_type(2)));
#define LAS __attribute__((address_space(3)))


__device__ __forceinline__ int otid() { int t = threadIdx.x; asm volatile("" : "+v"(t)); return t; }
__device__ __forceinline__ int obid() { int b = blockIdx.x; asm volatile("" : "+s"(b)); return b; }
struct KP { const float* in[30]; float* out; unsigned char* ws; int ph_lo, ph_hi; };
typedef const __attribute__((address_space(4))) KP* KPP;

__device__ __forceinline__ unsigned f2bf(float f) { unsigned u = __builtin_bit_cast(unsigned, f); return (u + 0x7fffu + ((u >> 16) & 1u)) >> 16; }
__device__ __forceinline__ unsigned pk2(float lo, float hi) { return f2bf(lo) | (f2bf(hi) << 16); }
__device__ __forceinline__ float bflo(unsigned w) { return __builtin_bit_cast(float, w << 16); }
__device__ __forceinline__ float bfhi(unsigned w) { return __builtin_bit_cast(float, w & 0xffff0000u); }
__device__ __forceinline__ void unpack8(u32x4 w, float* x) { x[0] = bflo(w.x); x[1] = bfhi(w.x); x[2] = bflo(w.y); x[3] = bfhi(w.y); x[4] = bflo(w.z); x[5] = bfhi(w.z); x[6] = bflo(w.w); x[7] = bfhi(w.w); }
__device__ __forceinline__ u32x4 pack8(const float* x) { u32x4 w; w.x = pk2(x[0], x[1]); w.y = pk2(x[2], x[3]); w.z = pk2(x[4], x[5]); w.w = pk2(x[6], x[7]); return w; }
__device__ __forceinline__ float wave_sum(float v) {
#pragma unroll
    for (int o = 1; o < 64; o <<= 1) v += __shfl_xor(v, o);
    return v;
}
template <int W> __device__ __forceinline__ float grp_sum(float v) {
#pragma unroll
    for (int o = 1; o < W; o <<= 1) v += __shfl_xor(v, o);
    return v;
}
__device__ __forceinline__ float silu_f(float x) { return x / (1.f + __expf(-x)); }

struct EpiF32 { static constexpr bool PERM = true, AFTER_DRAIN = false; float* O; int ldc;
    __device__ __forceinline__ void operator()(const pg8::f32x4 (&acc)[2][2][4][2], const pg8::Unit& u, int wr, int wc, int fr, int fq) const {
        const int row0 = u.pm * 256 + wr * 64 + fr, col0 = u.pn * 256 + wc * 32 + 8 * fq;
#pragma unroll
        for (int ai = 0; ai < 2; ++ai)
#pragma unroll
            for (int m = 0; m < 4; ++m) { float* rowp = O + (size_t)(row0 + ai * 128 + m * 16) * ldc + col0;
#pragma unroll
                for (int bj = 0; bj < 2; ++bj) { *(pg8::f32x4*)(rowp + bj * 128) = acc[ai][bj][m][0]; *(pg8::f32x4*)(rowp + bj * 128 + 4) = acc[ai][bj][m][1]; } }
    }
};
struct EpiRes { static constexpr bool PERM = true, AFTER_DRAIN = false;
    const void* src; void* dst; const float* mod; int gate_off; float* part; bool src16, dst16;
    __device__ __forceinline__ void operator()(const pg8::f32x4 (&acc)[2][2][4][2], const pg8::Unit& u, int wr, int wc, int fr, int fq) const {
        if (u.ks >= 0) {
            float* pb = part + ((size_t)u.ks * NCTX + (size_t)(u.pm - 64) * 256 + wr * 64 + fr) * DM + u.pn * 256 + wc * 32 + 8 * fq;
#pragma unroll
            for (int ai = 0; ai < 2; ++ai)
#pragma unroll
                for (int m = 0; m < 4; ++m)
#pragma unroll
                    for (int bj = 0; bj < 2; ++bj) { float* q = pb + (size_t)(ai * 128 + m * 16) * DM + bj * 128; *(pg8::f32x4*)q = acc[ai][bj][m][0]; *(pg8::f32x4*)(q + 4) = acc[ai][bj][m][1]; }
            return;
        }
        const float* g = mod + (size_t)(u.pm >> 4) * MOD6 + gate_off;
        const int lrow0 = u.pm * 256 + wr * 64 + fr, col0 = u.pn * 256 + wc * 32 + 8 * fq;
        pg8::f32x4 gv[2][2];
#pragma unroll
        for (int bj = 0; bj < 2; ++bj)
#pragma unroll
            for (int n = 0; n < 2; ++n) gv[bj][n] = *(const pg8::f32x4*)(g + col0 + bj * 128 + 4 * n);
#pragma unroll
        for (int ai = 0; ai < 2; ++ai)
#pragma unroll
            for (int m = 0; m < 4; ++m) { const size_t off = (size_t)(lrow0 + ai * 128 + m * 16) * DM + col0;
#pragma unroll
                for (int bj = 0; bj < 2; ++bj) {
                    pg8::f32x4 s0, s1;
                    if (src16) { const pg8::u32x4 w = *(const pg8::u32x4*)((const bf16_t*)src + off + bj * 128);
                        s0 = (pg8::f32x4){bflo(w.x), bfhi(w.x), bflo(w.y), bfhi(w.y)}; s1 = (pg8::f32x4){bflo(w.z), bfhi(w.z), bflo(w.w), bfhi(w.w)}; }
                    else { s0 = *(const pg8::f32x4*)((const float*)src + off + bj * 128); s1 = *(const pg8::f32x4*)((const float*)src + off + bj * 128 + 4); }
                    const pg8::f32x4 x0 = s0 + gv[bj][0] * acc[ai][bj][m][0], x1 = s1 + gv[bj][1] * acc[ai][bj][m][1];
                    if (dst16) { pg8::u32x4 w; w.x = pg8::cvt_pk_bf16(x0[0], x0[1]); w.y = pg8::cvt_pk_bf16(x0[2], x0[3]); w.z = pg8::cvt_pk_bf16(x1[0], x1[1]); w.w = pg8::cvt_pk_bf16(x1[2], x1[3]);
                        *(pg8::u32x4*)((bf16_t*)dst + off + bj * 128) = w; }
                    else { *(pg8::f32x4*)((float*)dst + off + bj * 128) = x0; *(pg8::f32x4*)((float*)dst + off + bj * 128 + 4) = x1; } } }
    }
};


__device__ __forceinline__ float dpp_ror1(float v) { return __builtin_bit_cast(float, __builtin_amdgcn_update_dpp(0, __builtin_bit_cast(int, v), 0x121, 0xf, 0xf, false)); }
__device__ __forceinline__ float dpp_ror15(float v) { return __builtin_bit_cast(float, __builtin_amdgcn_update_dpp(0, __builtin_bit_cast(int, v), 0x12F, 0xf, 0xf, false)); }
__device__ __forceinline__ pg8::f32x4 ror1_4(pg8::f32x4 v) { return (pg8::f32x4){dpp_ror1(v[0]), dpp_ror1(v[1]), dpp_ror1(v[2]), dpp_ror1(v[3])}; }
__device__ __forceinline__ pg8::f32x4 ror15_4(pg8::f32x4 v) { return (pg8::f32x4){dpp_ror15(v[0]), dpp_ror15(v[1]), dpp_ror15(v[2]), dpp_ror15(v[3])}; }
struct EpiConv { static constexpr bool PERM = true, AFTER_DRAIN = false;
    bf16_t* ACT; const float* cw; int nrows; LAS float* X;
    __device__ __forceinline__ void operator()(const pg8::f32x4 (&acc)[2][2][4][2], const pg8::Unit& u, int wr, int wc, int fr, int fq) const {
        typedef pg8::f32x4 v4;
        const int lc = wc * 32 + 8 * fq, ch0 = u.pn * 128 + lc;
#pragma unroll
        for (int ai = 0; ai < 2; ++ai) { const int gi = ai * 2 + wr;
#pragma unroll
            for (int bj = 0; bj < 2; ++bj)
#pragma unroll
                for (int n = 0; n < 2; ++n) {
                    if (fr == 0) *(LAS v4*)(X + (gi * 2 + 0) * 256 + bj * 128 + lc + 4 * n) = acc[ai][bj][0][n];
                    if (fr == 15) *(LAS v4*)(X + (gi * 2 + 1) * 256 + bj * 128 + lc + 4 * n) = acc[ai][bj][3][n];
                } }
        asm volatile("s_waitcnt lgkmcnt(0)" ::: "memory"); __builtin_amdgcn_s_barrier(); asm volatile("" ::: "memory");
        const v4 z4 = (v4){0.f, 0.f, 0.f, 0.f};
        unsigned pk[2][4][2], pk0[2][4][2];
#pragma unroll
        for (int n = 0; n < 2; ++n) {
            const v4 wa0 = *(const v4*)(cw + ch0 + 4 * n), wa1 = *(const v4*)(cw + DFF2 + ch0 + 4 * n), wa2 = *(const v4*)(cw + 2 * DFF2 + ch0 + 4 * n);
            const v4 wb0 = *(const v4*)(cw + DFF + ch0 + 4 * n), wb1 = *(const v4*)(cw + DFF2 + DFF + ch0 + 4 * n), wb2 = *(const v4*)(cw + 2 * DFF2 + DFF + ch0 + 4 * n);
#pragma unroll
            for (int ai = 0; ai < 2; ++ai) { const int gi = ai * 2 + wr;
                const v4 hpa = gi > 0 ? *(const LAS v4*)(X + ((gi - 1) * 2 + 1) * 256 + lc + 4 * n) : z4, hpb = gi > 0 ? *(const LAS v4*)(X + ((gi - 1) * 2 + 1) * 256 + 128 + lc + 4 * n) : z4;
                const v4 hna = gi < 3 ? *(const LAS v4*)(X + ((gi + 1) * 2 + 0) * 256 + lc + 4 * n) : z4, hnb = gi < 3 ? *(const LAS v4*)(X + ((gi + 1) * 2 + 0) * 256 + 128 + lc + 4 * n) : z4;
#pragma unroll
                for (int m = 0; m < 4; ++m) {
                    const int r = ai * 128 + wr * 64 + m * 16 + fr, R = 254 * u.pm - 1 + r;
                    const bool isctx = R >= NLAT; const int t = isctx ? ((R - NLAT) & (CTXL - 1)) : (R & (SEQ - 1));
                    const float mp = t != 0 ? 1.f : 0.f, mn = t != (isctx ? CTXL - 1 : SEQ - 1) ? 1.f : 0.f;
                    const v4 va = acc[ai][0][m][n], vb = acc[ai][1][m][n];
                    const v4 ra = ror1_4(va), rb = ror1_4(vb), la = ror15_4(va), lb = ror15_4(vb);
                    v4 pa, pb, na, nb;
                    if (m == 0) { pa = hpa; pb = hpb; } else { pa = ror1_4(acc[ai][0][m - 1][n]); pb = ror1_4(acc[ai][1][m - 1][n]); }
                    if (m == 3) { na = hna; nb = hnb; } else { na = ror15_4(acc[ai][0][m + 1][n]); nb = ror15_4(acc[ai][1][m + 1][n]); }
                    const v4 prev_a = fr == 0 ? pa : ra, prev_b = fr == 0 ? pb : rb, next_a = fr == 15 ? na : la, next_b = fr == 15 ? nb : lb;
                    const v4 ca = wa1 * va + (wa0 * prev_a) * mp + (wa2 * next_a) * mn;
                    const v4 cb = wb1 * vb + (wb0 * prev_b) * mp + (wb2 * next_b) * mn;
                    float y[4];
#pragma unroll
                    for (int i = 0; i < 4; ++i) y[i] = ca[i] * __builtin_amdgcn_rcpf(1.f + __builtin_amdgcn_exp2f(-1.4426950408889634f * ca[i])) * cb[i];
                    pk[ai][m][0] = pg8::cvt_pk_bf16(y[0], y[1]); pk[ai][m][1] = pg8::cvt_pk_bf16(y[2], y[3]);
                    if (n == 1) {
                    }
                    if (n == 0) { pk0[ai][m][0] = pk[ai][m][0]; pk0[ai][m][1] = pk[ai][m][1]; }
                    else if (r >= 1 && r <= 254 && R < nrows) {
                        pg8::u32x4 w; w.x = pk0[ai][m][0]; w.y = pk0[ai][m][1]; w.z = pk[ai][m][0]; w.w = pk[ai][m][1];
                        __builtin_nontemporal_store(w, (pg8::u32x4*)(ACT + (size_t)R * DFF + ch0)); }
                } }
        }
    }
};

struct SplitOrder {
    int nN, nlat, nsplit, G, c, npairs;
    __device__ __forceinline__ void init(int N, int K, int G_, int c_, bool has_ctx) { nN = N / 256; nlat = 64 * nN; nsplit = has_ctx ? 256 : 0; G = G_; c = c_; npairs = K / 128; }
    __device__ __forceinline__ bool next(int i, pg8::Unit& u) const {
        const int L = i * G + c;
        if (L >= nlat + nsplit) return false;
        int pm, pn, k0 = 0, nt = 0, ks = -1;
        if (L < nlat) {
            const int q = nlat / 8, xcd = L % 8, off = L / 8; const int wgid = xcd * q + off;
            const int nig = 4 * nN; const int gid = wgid / nig, fm = gid * 4;
            pm = fm + ((wgid % nig) % 4); pn = (wgid % nig) / 4;
        } else {
            const int s = L - nlat, base = npairs >> 3, rem = npairs & 7;
            ks = (s >> 3) & 7; pn = s & 7; pm = 64 + (s >> 6); k0 = 2 * (ks * base + min(ks, rem)); nt = 2 * (base + (ks < rem ? 1 : 0));
        }
        u.pm = pm; u.pn = pn; u.k0 = k0; u.nt = nt; u.ks = ks; return true;
    }
    __device__ __forceinline__ void a_ready(const pg8::Unit&) const {}
    __device__ __forceinline__ void done(const pg8::Unit&) const {}
};


struct EpiQK { static constexpr bool PERM = true, AFTER_DRAIN = false;
    bf16_t* O; const float* gains; LAS float* X;
    __device__ __forceinline__ void operator()(const pg8::f32x4 (&acc)[2][2][4][2], const pg8::Unit& u, int wr, int wc, int fr, int fq) const {
        typedef pg8::f32x4 v4;
        asm volatile("" : "+v"(fr), "+v"(fq));
        const int sec = u.pn >> 2;
        const int row0 = u.pm * 256 + wr * 64 + fr, colt = u.pn * 256;
        if (sec == 2 || sec == 5) {
            const int col0 = colt + wc * 32 + 8 * fq;
#pragma unroll
            for (int ai = 0; ai < 2; ++ai)
#pragma unroll
                for (int m = 0; m < 4; ++m) { bf16_t* rowp = O + (size_t)(row0 + ai * 128 + m * 16) * EPROJ + col0;
#pragma unroll
                    for (int bj = 0; bj < 2; ++bj) { const v4 v0 = acc[ai][bj][m][0], v1 = acc[ai][bj][m][1];
                        pg8::u32x4 w; w.x = pg8::cvt_pk_bf16(v0[0], v0[1]); w.y = pg8::cvt_pk_bf16(v0[2], v0[3]); w.z = pg8::cvt_pk_bf16(v1[0], v1[1]); w.w = pg8::cvt_pk_bf16(v1[2], v1[3]);
                        *(pg8::u32x4*)(rowp + bj * 128) = w; } }
            return;
        }
#pragma unroll
        for (int ai = 0; ai < 2; ++ai)
#pragma unroll
            for (int m = 0; m < 4; ++m)
#pragma unroll
                for (int bj = 0; bj < 2; ++bj) { const v4 a = acc[ai][bj][m][0], b = acc[ai][bj][m][1];
                    float sq = ((a[0] * a[0] + a[1] * a[1]) + (a[2] * a[2] + a[3] * a[3])) + ((b[0] * b[0] + b[1] * b[1]) + (b[2] * b[2] + b[3] * b[3]));
                    sq += __shfl_xor(sq, 16); sq += __shfl_xor(sq, 32);
                    if (fq == 0) X[((ai * 128 + wr * 64 + m * 16 + fr) * 2 + bj) * 4 + wc] = sq; }
        asm volatile("s_waitcnt lgkmcnt(0)" ::: "memory"); __builtin_amdgcn_s_barrier(); asm volatile("" ::: "memory");
        const bool perm = sec >= 3, rope = perm && u.pm < 64;
        const float* gain = gains + (sec < 2 ? sec : sec - 1) * 128;
        const int ld0 = perm ? 64 * (wc >> 1) + 16 * (wc & 1) + 4 * fq : 32 * wc + 8 * fq, ld1 = perm ? ld0 + 32 : ld0 + 4;
        const v4 g0 = *(const v4*)(gain + ld0), g1 = *(const v4*)(gain + ld1);
        float frev[4];
#pragma unroll
        for (int i = 0; i < 4; ++i) frev[i] = __builtin_amdgcn_exp2f(-13.287712379549449f * (float)((ld0 & 31) + i) * (1.f / 32.f)) * 0.15915494309189535f;
#pragma unroll
        for (int ai = 0; ai < 2; ++ai)
#pragma unroll
            for (int m = 0; m < 4; ++m) { const int row = row0 + ai * 128 + m * 16, t = row & (SEQ - 1); const float pos = (float)((wc >> 1) ? (t & 63) : (t >> 6));
                float cs[4], sn[4];
#pragma unroll
                for (int i = 0; i < 4; ++i) { const float rv = __builtin_amdgcn_fractf(pos * frev[i]); cs[i] = rope ? __builtin_amdgcn_cosf(rv) : 1.f; sn[i] = rope ? __builtin_amdgcn_sinf(rv) : 0.f; }
                bf16_t* rowp = O + (size_t)row * EPROJ + colt;
#pragma unroll
                for (int bj = 0; bj < 2; ++bj) { const v4 P4 = *(const LAS v4*)(X + ((ai * 128 + wr * 64 + m * 16 + fr) * 2 + bj) * 4);
                    const float rstd = rsqrtf(((P4[0] + P4[1]) + (P4[2] + P4[3])) * (1.f / 128.f) + EPS);
                    const v4 y0 = acc[ai][bj][m][0] * rstd * g0, y1 = acc[ai][bj][m][1] * rstd * g1;
                    float o0[4], o1[4];
#pragma unroll
                    for (int i = 0; i < 4; ++i) { o0[i] = y0[i] * cs[i] - y1[i] * sn[i]; o1[i] = y1[i] * cs[i] + y0[i] * sn[i]; }
                    u32x2 w0, w1; w0.x = pg8::cvt_pk_bf16(o0[0], o0[1]); w0.y = pg8::cvt_pk_bf16(o0[2], o0[3]); w1.x = pg8::cvt_pk_bf16(o1[0], o1[1]); w1.y = pg8::cvt_pk_bf16(o1[2], o1[3]);
                    *(u32x2*)(rowp + bj * 128 + ld0) = w0; *(u32x2*)(rowp + bj * 128 + ld1) = w1; } }
    }
};


struct EpiDown { static constexpr bool PERM = true, AFTER_DRAIN = false;
    bf16_t* QL; bf16_t* KVL; bf16_t* KR; float* SSKV; float* SSQ; const float* g_q; const float* g_kv; const float* g_kr; LAS float* X;
    __device__ __forceinline__ void operator()(const pg8::f32x4 (&acc)[2][2][4][2], const pg8::Unit& u, int wr, int wc, int fr, int fq) const {
        typedef pg8::f32x4 v4;
        asm volatile("" : "+v"(fr), "+v"(fq));
        const int row0 = u.pm * 256 + wr * 64 + fr, lc = wc * 32 + 8 * fq;
        if (u.pn < 4) {
            const bool isq = u.pn < 2; if (isq && u.pm >= 64) return;
            const int cb = (u.pn & 1) * 256 + lc; const float* gp = (isq ? g_q : g_kv) + cb; bf16_t* ob = (isq ? QL : KVL) + cb;
            v4 g[2][2];
#pragma unroll
            for (int bj = 0; bj < 2; ++bj) { g[bj][0] = *(const v4*)(gp + bj * 128); g[bj][1] = *(const v4*)(gp + bj * 128 + 4); }
#pragma unroll
            for (int ai = 0; ai < 2; ++ai)
#pragma unroll
                for (int m = 0; m < 4; ++m) { const int row = row0 + ai * 128 + m * 16; float sq = 0.f;
#pragma unroll
                    for (int bj = 0; bj < 2; ++bj) { const v4 a = acc[ai][bj][m][0], b = acc[ai][bj][m][1];
                        sq += ((a[0] * a[0] + a[1] * a[1]) + (a[2] * a[2] + a[3] * a[3])) + ((b[0] * b[0] + b[1] * b[1]) + (b[2] * b[2] + b[3] * b[3]));
                        const v4 y0 = a * g[bj][0], y1 = b * g[bj][1];
                        pg8::u32x4 w; w.x = pg8::cvt_pk_bf16(y0[0], y0[1]); w.y = pg8::cvt_pk_bf16(y0[2], y0[3]); w.z = pg8::cvt_pk_bf16(y1[0], y1[1]); w.w = pg8::cvt_pk_bf16(y1[2], y1[3]);
                        *(pg8::u32x4*)(ob + (size_t)row * 512 + bj * 128) = w; }
                    sq += __shfl_xor(sq, 16); sq += __shfl_xor(sq, 32); if (fq == 0) (isq ? SSQ : SSKV)[(size_t)row * 8 + (u.pn & 1) * 4 + wc] = sq; }
            return;
        }
#pragma unroll
        for (int ai = 0; ai < 2; ++ai)
#pragma unroll
            for (int m = 0; m < 4; ++m) { const v4 a = acc[ai][0][m][0], b = acc[ai][0][m][1];
                float sq = ((a[0] * a[0] + a[1] * a[1]) + (a[2] * a[2] + a[3] * a[3])) + ((b[0] * b[0] + b[1] * b[1]) + (b[2] * b[2] + b[3] * b[3]));
                sq += __shfl_xor(sq, 16); sq += __shfl_xor(sq, 32);
                if (fq == 0) X[(ai * 128 + wr * 64 + m * 16 + fr) * 4 + wc] = sq; }
        asm volatile("s_waitcnt lgkmcnt(0)" ::: "memory"); __builtin_amdgcn_s_barrier(); asm volatile("" ::: "memory");
        if (wc >= 2) return;
        const bool rope = u.pm < 64;
        const int ld0 = 32 * wc + 4 * fq, ld1 = ld0 + 16;
        const v4 g0 = *(const v4*)(g_kr + ld0), g1 = *(const v4*)(g_kr + ld1);
        float frev[4];
#pragma unroll
        for (int i = 0; i < 4; ++i) frev[i] = __builtin_amdgcn_exp2f(-13.287712379549449f * (float)(4 * fq + i) * (1.f / 16.f)) * 0.15915494309189535f;
#pragma unroll
        for (int ai = 0; ai < 2; ++ai)
#pragma unroll
            for (int m = 0; m < 4; ++m) { const int row = row0 + ai * 128 + m * 16, t = row & (SEQ - 1); const float pos = (float)(wc ? (t & 63) : (t >> 6));
                const v4 P4 = *(const LAS v4*)(X + (ai * 128 + wr * 64 + m * 16 + fr) * 4);
                const float rstd = rsqrtf((P4[0] + P4[1]) * (1.f / 64.f) + EPS);
                const v4 y0 = acc[ai][0][m][0] * rstd * g0, y1 = acc[ai][0][m][1] * rstd * g1;
                float o0[4], o1[4];
#pragma unroll
                for (int i = 0; i < 4; ++i) { const float rv = __builtin_amdgcn_fractf(pos * frev[i]); const float c = rope ? __builtin_amdgcn_cosf(rv) : 1.f, sn = rope ? __builtin_amdgcn_sinf(rv) : 0.f;
                    o0[i] = y0[i] * c - y1[i] * sn; o1[i] = y1[i] * c + y0[i] * sn; }
                u32x2 w0, w1; w0.x = pg8::cvt_pk_bf16(o0[0], o0[1]); w0.y = pg8::cvt_pk_bf16(o0[2], o0[3]); w1.x = pg8::cvt_pk_bf16(o1[0], o1[1]); w1.y = pg8::cvt_pk_bf16(o1[2], o1[3]);
                *(u32x2*)(KR + (size_t)row * 64 + ld0) = w0; *(u32x2*)(KR + (size_t)row * 64 + ld1) = w1; }
    }
};

struct EpiKV { static constexpr bool PERM = true, AFTER_DRAIN = false;
    bf16_t* O; const float* gain; LAS float* X; const float* SSKV;
    __device__ __forceinline__ void operator()(const pg8::f32x4 (&acc)[2][2][4][2], const pg8::Unit& u, int wr, int wc, int fr, int fq) const {
        typedef pg8::f32x4 v4;
        asm volatile("" : "+v"(fr), "+v"(fq));
        const int row0 = u.pm * 256 + wr * 64 + fr, col0 = u.pn * 256 + wc * 32 + 8 * fq;
        v4 sk[2][4][2];
#pragma unroll
        for (int ai = 0; ai < 2; ++ai)
#pragma unroll
            for (int m = 0; m < 4; ++m) { const float* q = SSKV + (size_t)(row0 + ai * 128 + m * 16) * 8; sk[ai][m][0] = *(const v4*)q; sk[ai][m][1] = *(const v4*)(q + 4); }
        float rkv[2][4];
#pragma unroll
        for (int ai = 0; ai < 2; ++ai)
#pragma unroll
            for (int m = 0; m < 4; ++m) { const v4 sa = sk[ai][m][0], sb = sk[ai][m][1];
                rkv[ai][m] = rsqrtf((((sa[0] + sa[1]) + (sa[2] + sa[3])) + ((sb[0] + sb[1]) + (sb[2] + sb[3]))) * (1.f / 512.f) + EPS);
                const v4 a = acc[ai][0][m][0] * rkv[ai][m], b = acc[ai][0][m][1] * rkv[ai][m];
                float sq = ((a[0] * a[0] + a[1] * a[1]) + (a[2] * a[2] + a[3] * a[3])) + ((b[0] * b[0] + b[1] * b[1]) + (b[2] * b[2] + b[3] * b[3]));
                sq += __shfl_xor(sq, 16); sq += __shfl_xor(sq, 32);
                if (fq == 0) X[(ai * 128 + wr * 64 + m * 16 + fr) * 4 + wc] = sq; }
        asm volatile("s_waitcnt lgkmcnt(0)" ::: "memory"); __builtin_amdgcn_s_barrier(); asm volatile("" ::: "memory");
        const v4 g0 = *(const v4*)(gain + wc * 32 + 8 * fq), g1 = *(const v4*)(gain + wc * 32 + 8 * fq + 4);
#pragma unroll
        for (int ai = 0; ai < 2; ++ai)
#pragma unroll
            for (int m = 0; m < 4; ++m) { const v4 P4 = *(const LAS v4*)(X + (ai * 128 + wr * 64 + m * 16 + fr) * 4);
                const float rstd = rsqrtf(((P4[0] + P4[1]) + (P4[2] + P4[3])) * (1.f / 128.f) + EPS) * rkv[ai][m];
                bf16_t* rowp = O + (size_t)(row0 + ai * 128 + m * 16) * KVW + col0;
                const v4 k0 = acc[ai][0][m][0] * rstd * g0, k1 = acc[ai][0][m][1] * rstd * g1, v0 = acc[ai][1][m][0] * rkv[ai][m], v1 = acc[ai][1][m][1] * rkv[ai][m];
                pg8::u32x4 w; w.x = pg8::cvt_pk_bf16(k0[0], k0[1]); w.y = pg8::cvt_pk_bf16(k0[2], k0[3]); w.z = pg8::cvt_pk_bf16(k1[0], k1[1]); w.w = pg8::cvt_pk_bf16(k1[2], k1[3]);
                *(pg8::u32x4*)rowp = w;
                w.x = pg8::cvt_pk_bf16(v0[0], v0[1]); w.y = pg8::cvt_pk_bf16(v0[2], v0[3]); w.z = pg8::cvt_pk_bf16(v1[0], v1[1]); w.w = pg8::cvt_pk_bf16(v1[2], v1[3]);
                *(pg8::u32x4*)(rowp + 128) = w; }
    }
};
struct EpiQ1 { static constexpr bool PERM = true, AFTER_DRAIN = false;
    bf16_t* O; const float* g_nope; const float* g_rope; LAS float* X; const float* SSQ;
    __device__ __forceinline__ void operator()(const pg8::f32x4 (&acc)[2][2][4][2], const pg8::Unit& u, int wr, int wc, int fr, int fq) const {
        typedef pg8::f32x4 v4;
        asm volatile("" : "+v"(fr), "+v"(fq));
        const bool rp = u.pn >= 8;
        const int row0 = u.pm * 256 + wr * 64 + fr, colt = u.pn * 256;
        v4 sk[2][4][2];
#pragma unroll
        for (int ai = 0; ai < 2; ++ai)
#pragma unroll
            for (int m = 0; m < 4; ++m) { const float* q = SSQ + (size_t)(row0 + ai * 128 + m * 16) * 8; sk[ai][m][0] = *(const v4*)q; sk[ai][m][1] = *(const v4*)(q + 4); }
        float rq[2][4];
#pragma unroll
        for (int ai = 0; ai < 2; ++ai)
#pragma unroll
            for (int m = 0; m < 4; ++m) { const v4 sa = sk[ai][m][0], sb = sk[ai][m][1]; rq[ai][m] = rsqrtf((((sa[0] + sa[1]) + (sa[2] + sa[3])) + ((sb[0] + sb[1]) + (sb[2] + sb[3]))) * (1.f / 512.f) + EPS); }
#pragma unroll
        for (int ai = 0; ai < 2; ++ai)
#pragma unroll
            for (int m = 0; m < 4; ++m)
#pragma unroll
                for (int bj = 0; bj < 2; ++bj) { const v4 a = acc[ai][bj][m][0] * rq[ai][m], b = acc[ai][bj][m][1] * rq[ai][m];
                    float sq = ((a[0] * a[0] + a[1] * a[1]) + (a[2] * a[2] + a[3] * a[3])) + ((b[0] * b[0] + b[1] * b[1]) + (b[2] * b[2] + b[3] * b[3]));
                    sq += __shfl_xor(sq, 16); sq += __shfl_xor(sq, 32);
                    if (fq == 0) X[((ai * 128 + wr * 64 + m * 16 + fr) * 2 + bj) * 4 + wc] = sq; }
        asm volatile("s_waitcnt lgkmcnt(0)" ::: "memory"); __builtin_amdgcn_s_barrier(); asm volatile("" ::: "memory");
        const int ld0 = rp ? 32 * (wc & 1) + 4 * fq : 32 * wc + 8 * fq, ld1 = rp ? ld0 + 16 : ld0 + 4;
        const float* gain = rp ? g_rope : g_nope;
        const v4 g0 = *(const v4*)(gain + ld0), g1 = *(const v4*)(gain + ld1);
        float frev[4];
#pragma unroll
        for (int i = 0; i < 4; ++i) frev[i] = __builtin_amdgcn_exp2f(-13.287712379549449f * (float)(4 * fq + i) * (1.f / 16.f)) * 0.15915494309189535f;
#pragma unroll
        for (int ai = 0; ai < 2; ++ai)
#pragma unroll
            for (int m = 0; m < 4; ++m) { const int row = row0 + ai * 128 + m * 16, t = row & (SEQ - 1); const float pos = (float)((wc & 1) ? (t & 63) : (t >> 6));
                float cs[4], sn[4];
#pragma unroll
                for (int i = 0; i < 4; ++i) { const float rv = __builtin_amdgcn_fractf(pos * frev[i]); cs[i] = rp ? __builtin_amdgcn_cosf(rv) : 1.f; sn[i] = rp ? __builtin_amdgcn_sinf(rv) : 0.f; }
                bf16_t* rowp = O + (size_t)row * QW + colt;
#pragma unroll
                for (int bj = 0; bj < 2; ++bj) { const v4 P4 = *(const LAS v4*)(X + ((ai * 128 + wr * 64 + m * 16 + fr) * 2 + bj) * 4);
                    const float ssum = rp ? ((wc >> 1) ? (P4[2] + P4[3]) : (P4[0] + P4[1])) : ((P4[0] + P4[1]) + (P4[2] + P4[3]));
                    const float rstd = rsqrtf(ssum * (rp ? (1.f / 64.f) : (1.f / 128.f)) + EPS) * rq[ai][m];
                    const v4 y0 = acc[ai][bj][m][0] * rstd * g0, y1 = acc[ai][bj][m][1] * rstd * g1;
                    float o0[4], o1[4];
#pragma unroll
                    for (int i = 0; i < 4; ++i) { o0[i] = y0[i] * cs[i] - y1[i] * sn[i]; o1[i] = y1[i] * cs[i] + y0[i] * sn[i]; }
                    u32x2 w0, w1; w0.x = pg8::cvt_pk_bf16(o0[0], o0[1]); w0.y = pg8::cvt_pk_bf16(o0[2], o0[3]); w1.x = pg8::cvt_pk_bf16(o1[0], o1[1]); w1.y = pg8::cvt_pk_bf16(o1[2], o1[3]);
                    const int hb = rp ? bj * 128 + (wc >> 1) * 64 : bj * 128;
                    *(u32x2*)(rowp + hb + ld0) = w0; *(u32x2*)(rowp + hb + ld1) = w1; } }
    }
};

namespace att {
constexpr int NW = 8, QBLK = 32, KVBLK = 64;
constexpr int SHM_V = 16384, SHM_K = 16384, SHM_KR = 8192;
constexpr int OFF_V = 0, OFF_K = 32768, OFF_KR = 65536, OFF_WS = 81920, OFF_TAB = 83968, OFF_QR = 86016, LDS_BYTES = 86016 + 32768;
constexpr float THR = 8.f;
#define KSWZ(row, colB) ((row) * 256 + ((colB) ^ (((row) & 7) << 4)))
#define KRSWZ(row, colB) ((row) * 128 + ((colB) ^ (((row) & 7) << 4)))
#define SBAR() __builtin_amdgcn_sched_barrier(0)
__device__ __forceinline__ int crow(int r, int hi) { return (r & 3) + 8 * (r >> 2) + 4 * hi; }
__device__ __forceinline__ unsigned cvtpk(float lo, float hi) { unsigned r; asm volatile("v_cvt_pk_bf16_f32 %0, %1, %2" : "=v"(r) : "v"(lo), "v"(hi)); return r; }

struct AUnit {
    const bf16_t* Q; int ldq;
    const bf16_t* K; const bf16_t* V; int ldk;
    const bf16_t* KR;
    int base0, n0, base1, NT;
    void* O; int ldo;
    int qrow0, krow0;
    int qroff;
};

template <int MODE> __device__ __forceinline__ void partialSM(f32x16& p0, f32x16& p1, float& m_reg, float& mn, float& alpha) {
    constexpr float SCALE = MODE == 2 ? 0.07216878364870322f : 0.08838834764831845f;
    constexpr float C = SCALE * 1.4426950408889634f;
    float pmax = p0[0];
#pragma unroll
    for (int r = 1; r < 16; ++r) pmax = fmaxf(pmax, p0[r]);
#pragma unroll
    for (int r = 0; r < 16; ++r) pmax = fmaxf(pmax, p1[r]);
    { auto rr = __builtin_amdgcn_permlane32_swap(__float_as_uint(pmax), __float_as_uint(pmax), false, false);
      pmax = fmaxf(__uint_as_float(rr[0]), __uint_as_float(rr[1])); }
    if (__builtin_expect(__all(pmax - m_reg <= THR / SCALE), 1)) { mn = m_reg; alpha = 1.f; }
    else { mn = fmaxf(m_reg, pmax); alpha = __builtin_amdgcn_exp2f((m_reg - mn) * C); m_reg = mn; }
    const float mnC = -mn * C;
#pragma unroll
    for (int r = 0; r < 16; ++r) p0[r] = fmaf(p0[r], C, mnC);
#pragma unroll
    for (int r = 0; r < 16; ++r) p1[r] = fmaf(p1[r], C, mnC);
#pragma unroll
    for (int r = 0; r < 16; ++r) p0[r] = __builtin_amdgcn_exp2f(p0[r]);
}
__device__ __forceinline__ void finishSM(f32x16& p0, f32x16& p1, float alpha, float& l_reg, bf16x8& pa0, bf16x8& pa1, bf16x8& pa2, bf16x8& pa3) {
#pragma unroll
    for (int r = 0; r < 16; ++r) p1[r] = __builtin_amdgcn_exp2f(p1[r]);
    float ps = 0;
#pragma unroll
    for (int r = 0; r < 16; ++r) ps += p0[r];
#pragma unroll
    for (int r = 0; r < 16; ++r) ps += p1[r];
    { auto rr = __builtin_amdgcn_permlane32_swap(__float_as_uint(ps), __float_as_uint(ps), false, false);
      ps = __uint_as_float(rr[0]) + __uint_as_float(rr[1]); }
    l_reg = l_reg * alpha + ps;
#define PK4(P, BASE, OUT) do { unsigned a0 = cvtpk(P[BASE + 0], P[BASE + 1]), a1 = cvtpk(P[BASE + 2], P[BASE + 3]);   \
    unsigned b0 = cvtpk(P[BASE + 4], P[BASE + 5]), b1 = cvtpk(P[BASE + 6], P[BASE + 7]);                              \
    auto r0 = __builtin_amdgcn_permlane32_swap(a0, b0, false, false); auto r1 = __builtin_amdgcn_permlane32_swap(a1, b1, false, false); \
    u32x4 w = {r0[0], r1[0], r0[1], r1[1]}; OUT = *reinterpret_cast<bf16x8*>(&w); } while (0)
    PK4(p0, 0, pa0); PK4(p0, 8, pa1); PK4(p1, 0, pa2); PK4(p1, 8, pa3);
#undef PK4
}
template <int MODE> __device__ __forceinline__ void qkt(f32x16& p0, f32x16& p1, const char* Ks, const char* KRs, const bf16x8* qr, const char* qrl, int r32, int hi) {
    p0 = f32x16{}; p1 = f32x16{};
#pragma unroll
    for (int d0 = 0; d0 < 8; ++d0) { const int cb = (d0 * 16 + hi * 8) * 2;
        bf16x8 b0 = *reinterpret_cast<const bf16x8*>(Ks + KSWZ(r32, cb));
        bf16x8 b1 = *reinterpret_cast<const bf16x8*>(Ks + KSWZ(32 + r32, cb));
        bf16x8 qv; if (MODE == 1 && d0 >= 4) qv = *reinterpret_cast<const bf16x8*>(qrl + (d0 - 4) * 1024); else qv = qr[d0];
        p0 = __builtin_amdgcn_mfma_f32_32x32x16_bf16(b0, qv, p0, 0, 0, 0);
        p1 = __builtin_amdgcn_mfma_f32_32x32x16_bf16(b1, qv, p1, 0, 0, 0); }
    if constexpr (MODE == 2) {
#pragma unroll
        for (int d0 = 0; d0 < 4; ++d0) { const int cb = (d0 * 16 + hi * 8) * 2;
            bf16x8 b0 = *reinterpret_cast<const bf16x8*>(KRs + KRSWZ(r32, cb));
            bf16x8 b1 = *reinterpret_cast<const bf16x8*>(KRs + KRSWZ(32 + r32, cb));
            const bf16x8 qv = *reinterpret_cast<const bf16x8*>(qrl + d0 * 1024);
            p0 = __builtin_amdgcn_mfma_f32_32x32x16_bf16(b0, qv, p0, 0, 0, 0);
            p1 = __builtin_amdgcn_mfma_f32_32x32x16_bf16(b1, qv, p1, 0, 0, 0); }
    }
}
__device__ __forceinline__ int v_st(int k, int c) { const int kk = (k & ~0xC) | ((k & 4) << 1) | ((k & 8) >> 1); return ((kk >> 3) * 4 + (c >> 5)) * 512 + ((kk & 7) * 32 + (c & 31)) * 2; }
__device__ __forceinline__ int v_rd_base(int lane) { return ((lane & 3) << 3) | (((lane >> 2) & 3) << 6) | (((lane >> 4) & 1) << 5) | (((lane >> 5) & 1) << 8); }
constexpr int v_rd_off(int d0, int ks, int half) { return d0 * 512 + ks * 4096 + half * 2048; }
template <int OFF> __device__ __forceinline__ s16x4 tr_read(int vb) {
    s16x4 r; asm volatile("ds_read_b64_tr_b16 %0, %1 offset:%2" : "=&v"(r) : "v"(vb), "i"(OFF) : "memory"); return r;
}
template <int D0> __device__ __forceinline__ void pv_one(f32x16& od, int vb, bf16x8 pa0, bf16x8 pa1, bf16x8 pa2, bf16x8 pa3) {
    const s16x4 l0 = tr_read<v_rd_off(D0, 0, 0)>(vb), h0 = tr_read<v_rd_off(D0, 0, 1)>(vb), l1 = tr_read<v_rd_off(D0, 1, 0)>(vb), h1 = tr_read<v_rd_off(D0, 1, 1)>(vb);
    const s16x4 l2 = tr_read<v_rd_off(D0, 2, 0)>(vb), h2 = tr_read<v_rd_off(D0, 2, 1)>(vb), l3 = tr_read<v_rd_off(D0, 3, 0)>(vb), h3 = tr_read<v_rd_off(D0, 3, 1)>(vb);
    asm volatile("s_waitcnt lgkmcnt(0)" ::: "memory"); SBAR();
#define PK(L, H) (bf16x8){L[0], L[1], L[2], L[3], H[0], H[1], H[2], H[3]}
    od = __builtin_amdgcn_mfma_f32_32x32x16_bf16(pa0, PK(l0, h0), od, 0, 0, 0);
    od = __builtin_amdgcn_mfma_f32_32x32x16_bf16(pa1, PK(l1, h1), od, 0, 0, 0);
    od = __builtin_amdgcn_mfma_f32_32x32x16_bf16(pa2, PK(l2, h2), od, 0, 0, 0);
    od = __builtin_amdgcn_mfma_f32_32x32x16_bf16(pa3, PK(l3, h3), od, 0, 0, 0);
#undef PK
}
__device__ __forceinline__ void pv_d0(f32x16* o, int vb, bf16x8 pa0, bf16x8 pa1, bf16x8 pa2, bf16x8 pa3) {
    pv_one<0>(o[0], vb, pa0, pa1, pa2, pa3); pv_one<1>(o[1], vb, pa0, pa1, pa2, pa3); pv_one<2>(o[2], vb, pa0, pa1, pa2, pa3); pv_one<3>(o[3], vb, pa0, pa1, pa2, pa3);
}
__device__ __forceinline__ void na_mask(f32x16& p0, f32x16& p1, int j, int n0, int qrow0, int krow0, int wid, int r32, int hi, const float* tab) {
    if (j >= n0) return;
    const int qrow = qrow0 + (wid >> 1), c = (wid & 1) * 32 + r32, kr = krow0 + j;
    const int rs = min(max(qrow - 4, 0), 56);
    const float NEG = -INFINITY;
    if (kr < rs || kr >= rs + 8) {
#pragma unroll
        for (int r = 0; r < 16; ++r) { p0[r] = NEG; p1[r] = NEG; }
        return;
    }
    const int dr = kr - qrow + 7, cs = min(max(c - 8, 0), 48);
    const float* trow = tab + dr * 31 + 15 - c + cs;
#pragma unroll
    for (int r = 0; r < 16; ++r) {
        const int i0 = crow(r, hi) - cs, i1 = i0 + 32;
        const bool v0 = (unsigned)i0 < 16u, v1 = (unsigned)i1 < 16u;
        const float b0 = trow[min(max(i0, 0), 15)], b1 = trow[min(max(i1, 0), 15)];
        p0[r] = v0 ? p0[r] + b0 : NEG; p1[r] = v1 ? p1[r] + b1 : NEG;
        if ((r & 3) == 3) SBAR();
    }
}

template <int MODE, bool OUTF32>
__device__ __forceinline__ void attn_unit(const AUnit& u, char* lds) {
    const int tid = otid(), wid = tid >> 6, lane = tid & 63, r32 = lane & 31, hi = lane >> 5;
    char* V_lds = lds + OFF_V; char* K_lds = lds + OFF_K; char* KR_lds = lds + OFF_KR;
    float* ws = (float*)(lds + OFF_WS) + wid * 64; float* li_l = ws; float* al_l = ws + 32;
    const float* tab = (const float*)(lds + OFF_TAB);
    float m_reg = -1e30f, l_reg = 0; f32x16 o[4] = {}; bf16x8 qr[8]; char* qrl = lds + OFF_QR + wid * 4096 + lane * 16;
    const bf16_t* Qw = u.Q + (size_t)(wid * QBLK + r32) * u.ldq + hi * 8;
#pragma unroll
    for (int d0 = 0; d0 < (MODE == 1 ? 4 : 8); ++d0) qr[d0] = *reinterpret_cast<const bf16x8*>(Qw + d0 * 16);
    if constexpr (MODE == 1) {
#pragma unroll
        for (int d0 = 0; d0 < 4; ++d0) { qr[4 + d0] = qr[d0]; *reinterpret_cast<bf16x8*>(qrl + d0 * 1024) = *reinterpret_cast<const bf16x8*>(Qw + 64 + d0 * 16); }
    }
    if constexpr (MODE == 2) {
#pragma unroll
        for (int d0 = 0; d0 < 4; ++d0) *reinterpret_cast<bf16x8*>(qrl + d0 * 1024) = *reinterpret_cast<const bf16x8*>(Qw + u.qroff + d0 * 16);
    }
    const int sr = tid >> 4, sc = (tid & 15) * 8, vst0 = v_st(sr, sc), vst1 = v_st(32 + sr, sc);
    const int krr = tid >> 3, krc = (tid & 7) * 8;
    const unsigned voff0 = (unsigned)(sr * u.ldk + sc) * 2u, voff1 = voff0 + 64u * (unsigned)u.ldk, voffr = (unsigned)(krr * 64 + krc) * 2u;
    const int vb0 = (int)(uintptr_t)(LAS char*)V_lds + v_rd_base(lane);
    constexpr int SD = 1;
    struct { bf16x8 vs0, vs1, ks0, ks1, kr; } sr_[SD];
#define TROW(j) ((j) < u.n0 ? u.base0 + 64 * (j) : u.base1 + 64 * ((j) - u.n0))
#define SLOAD(i, jt) do { const int _r = __builtin_amdgcn_readfirstlane(TROW(jt)); const char* _vb = (const char*)(u.V + (size_t)_r * u.ldk); const char* _kb = (const char*)(u.K + (size_t)_r * u.ldk); \
    sr_[i].vs0 = *reinterpret_cast<const bf16x8*>(_vb + voff0); sr_[i].vs1 = *reinterpret_cast<const bf16x8*>(_vb + voff1); \
    sr_[i].ks0 = *reinterpret_cast<const bf16x8*>(_kb + voff0); sr_[i].ks1 = *reinterpret_cast<const bf16x8*>(_kb + voff1); \
    if constexpr (MODE == 2) sr_[i].kr = *reinterpret_cast<const bf16x8*>((const char*)(u.KR + (size_t)_r * 64) + voffr); } while (0)
#define SWRITE(b, i) do { *(bf16x8*)(V_lds + (b) * SHM_V + vst0) = sr_[i].vs0; *(bf16x8*)(V_lds + (b) * SHM_V + vst1) = sr_[i].vs1; const int kc = sc * 2; \
    *(bf16x8*)(K_lds + (b) * SHM_K + KSWZ(sr, kc)) = sr_[i].ks0; *(bf16x8*)(K_lds + (b) * SHM_K + KSWZ(32 + sr, kc)) = sr_[i].ks1; \
    if constexpr (MODE == 2) *(bf16x8*)(KR_lds + (b) * SHM_KR + KRSWZ(krr, krc * 2)) = sr_[i].kr; } while (0)
#define SWAIT() do { if constexpr (SD == 1) asm volatile("s_waitcnt vmcnt(0)" ::: "memory"); else if constexpr (MODE == 2) asm volatile("s_waitcnt vmcnt(5)" ::: "memory"); else asm volatile("s_waitcnt vmcnt(4)" ::: "memory"); } while (0)
#define RESC(a) do { if (__any((a) < 1.f)) { if (hi == 0) al_l[r32] = (a); asm volatile("s_waitcnt lgkmcnt(0)" ::: "memory"); \
    _Pragma("unroll") for (int d = 0; d < 4; ++d) _Pragma("unroll") for (int r = 0; r < 16; ++r) o[d][r] *= al_l[crow(r, hi)]; } } while (0)
#ifdef DIS_NA
#define MASK(P0, P1, jt) do {} while (0)
#else
#define MASK(P0, P1, jt) do { if constexpr (MODE == 1) na_mask(P0, P1, (jt), u.n0, u.qrow0, u.krow0, wid, r32, hi, tab); } while (0)
#endif
    f32x16 pA0, pA1, pB0, pB1; float mnA, mnB, alA, alB; bf16x8 pa0, pa1, pa2, pa3; const int NT = u.NT;
    constexpr int SE = 0, SO = SD - 1;
    SLOAD(SE, 0); asm volatile("s_waitcnt vmcnt(0)" ::: "memory"); SWRITE(0, SE); __syncthreads();
    qkt<MODE>(pA0, pA1, K_lds, KR_lds, qr, qrl, r32, hi); MASK(pA0, pA1, 0); partialSM<MODE>(pA0, pA1, m_reg, mnA, alA);
    SLOAD(SO, 1); if constexpr (SD == 2) { if (2 < NT) SLOAD(SE, 2); }
    SWAIT(); SWRITE(1, SO); __syncthreads();
    for (int j = 1; j + 1 < NT; j += 2) {
        SBAR(); qkt<MODE>(pB0, pB1, K_lds + SHM_K, KR_lds + SHM_KR, qr, qrl, r32, hi);
        finishSM(pA0, pA1, alA, l_reg, pa0, pa1, pa2, pa3); SBAR();
        SLOAD(SO, j + SD); SBAR();
        pv_d0(o, vb0, pa0, pa1, pa2, pa3); MASK(pB0, pB1, j); partialSM<MODE>(pB0, pB1, m_reg, mnB, alB);
        __syncthreads(); SWAIT(); SWRITE(0, SE);
        RESC(alB); __syncthreads();
        SBAR(); qkt<MODE>(pA0, pA1, K_lds, KR_lds, qr, qrl, r32, hi);
        finishSM(pB0, pB1, alB, l_reg, pa0, pa1, pa2, pa3); SBAR();
        if (SD == 1 || j + 3 < NT) SLOAD(SE, j + 1 + SD); SBAR();
        pv_d0(o, vb0 + SHM_V, pa0, pa1, pa2, pa3); MASK(pA0, pA1, j + 1); partialSM<MODE>(pA0, pA1, m_reg, mnA, alA);
        __syncthreads(); SWAIT(); SWRITE(1, SO);
        RESC(alA); __syncthreads();
    }
    SBAR(); qkt<MODE>(pB0, pB1, K_lds + SHM_K, KR_lds + SHM_KR, qr, qrl, r32, hi);
    finishSM(pA0, pA1, alA, l_reg, pa0, pa1, pa2, pa3); SBAR();
    pv_d0(o, vb0, pa0, pa1, pa2, pa3); MASK(pB0, pB1, NT - 1); partialSM<MODE>(pB0, pB1, m_reg, mnB, alB);
    __syncthreads(); RESC(alB);
    finishSM(pB0, pB1, alB, l_reg, pa0, pa1, pa2, pa3); SBAR();
    pv_d0(o, vb0 + SHM_V, pa0, pa1, pa2, pa3);
    if (hi == 0) li_l[r32] = l_reg; asm volatile("s_waitcnt lgkmcnt(0)" ::: "memory");
    float rli[16];
#pragma unroll
    for (int r = 0; r < 16; ++r) rli[r] = __builtin_amdgcn_rcpf(li_l[crow(r, hi)]);
    if constexpr (OUTF32) {
        float* Ow = (float*)u.O + (size_t)(wid * QBLK) * u.ldo;
#pragma unroll
        for (int r = 0; r < 16; ++r) { const int orow = crow(r, hi);
#pragma unroll
            for (int d0 = 0; d0 < 4; ++d0) Ow[(size_t)orow * u.ldo + d0 * 32 + r32] = o[d0][r] * rli[r]; }
    } else {
        bf16_t* Ow = (bf16_t*)u.O + (size_t)(wid * QBLK) * u.ldo;
#pragma unroll
        for (int r = 0; r < 16; ++r) { const int orow = crow(r, hi);
#pragma unroll
            for (int d0 = 0; d0 < 4; ++d0) Ow[(size_t)orow * u.ldo + d0 * 32 + r32] = (bf16_t)f2bf(o[d0][r] * rli[r]); }
    }
    __syncthreads();
#undef TROW
#undef SLOAD
#undef SWRITE
#undef SWAIT
#undef RESC
#undef MASK
}
}

constexpr int LDS_BYTES = 147456;

__device__ __forceinline__ int ein_rowmap(int col) {
    if (col < 3072 || col >= 5120) return col;
    const int ld = col & 127, blk = ld >> 6, r = ld & 63, n = r >> 5, r2 = r & 31;
    return (col & ~127) + 32 * (2 * blk + (r2 >> 4)) + 8 * ((r2 >> 2) & 3) + 4 * n + (r2 & 3);
}
__device__ __forceinline__ int uq_rowmap(int c) {
    const int h = c / 192, r = c - h * 192;
    if (r < 128) return h * 128 + r;
    const int rr = r - 128, ld = rr & 31;
    return 2048 + h * 64 + (rr & 32) + 8 * ((ld >> 2) & 3) + 4 * (ld >> 4) + (ld & 3);
}
__device__ __forceinline__ int down_rowmap(int c) {
    if (c < 1024) return c;
    const int rr = c - 1024, ld = rr & 31;
    return 1024 + (rr & 32) + 8 * ((ld >> 2) & 3) + 4 * (ld >> 4) + (ld & 3);
}
__device__ __forceinline__ void transpose_item(const float* W, int K, int N, bf16_t* WT, int drow0, int k0, int n0, LAS float* scr, int lane, int rmap) {
    typedef float f32x2 __attribute__((ext_vector_type(2)));
    const float* src = W + (size_t)(k0 + (lane >> 5)) * N + n0 + 2 * (lane & 31); LAS float* dsts = scr + (lane >> 5) * 66 + 2 * (lane & 31);
#pragma unroll 16
    for (int i = 0; i < 32; ++i) *(LAS f32x2*)(dsts + i * 132) = *(const f32x2*)(src + (size_t)(2 * i) * N);
    asm volatile("s_waitcnt lgkmcnt(0)" ::: "memory");
    const int c = lane & 7;
#pragma unroll
    for (int j = 0; j < 8; ++j) { const int n = (lane >> 3) + 8 * j; const LAS float* s = scr + (8 * c) * 66 + n;
        u32x4 o; o.x = pk2(s[0 * 66], s[1 * 66]); o.y = pk2(s[2 * 66], s[3 * 66]); o.z = pk2(s[4 * 66], s[5 * 66]); o.w = pk2(s[6 * 66], s[7 * 66]);
        *(u32x4*)(WT + (size_t)(rmap == 1 ? ein_rowmap(drow0 + n) : rmap == 2 ? uq_rowmap(drow0 + n) : rmap == 3 ? down_rowmap(drow0 + n) : drow0 + n) * K + k0 + 8 * c) = o; }
    asm volatile("s_waitcnt lgkmcnt(0)" ::: "memory");
}
__device__ __forceinline__ int ffn_rowmap(int n) { return n < DFF ? (n >> 7) * 256 + (n & 127) : ((n - DFF) >> 7) * 256 + 128 + ((n - DFF) & 127); }

__device__ __forceinline__ void phase_prologue(KPP p, unsigned char* lds) {
    const int tid = otid(), lane = tid & 63, wave = tid >> 6;
    const int gw = obid() * 8 + wave, NGW = gridDim.x * 8;
    unsigned char* ws = p->ws;
    if (obid() == 0) {
        { float* gn = (float*)(ws + WS_GAINS); if (tid < 128) { gn[tid] = p->in[13][tid]; gn[128 + tid] = p->in[14][tid]; gn[256 + tid] = p->in[16][tid]; gn[384 + tid] = p->in[17][tid]; } }
        float2* t128 = (float2*)(ws + WS_TAB128); float2* t64 = (float2*)(ws + WS_TAB64);
        for (int i = tid; i < 64 * 32; i += 512) { const int pos = i >> 5, f = i & 31; const float fr = __builtin_amdgcn_exp2f(-13.287712379549449f * (float)f * (1.f / 32.f));
            float rv = (float)pos * fr * 0.15915494309189535f; rv -= rintf(rv); t128[i] = make_float2(__builtin_amdgcn_cosf(rv), __builtin_amdgcn_sinf(rv)); }
        for (int i = tid; i < 64 * 16; i += 512) { const int pos = i >> 4, f = i & 15; const float fr = __builtin_amdgcn_exp2f(-13.287712379549449f * (float)f * (1.f / 16.f));
            float rv = (float)pos * fr * 0.15915494309189535f; rv -= rintf(rv); t64[i] = make_float2(__builtin_amdgcn_cosf(rv), __builtin_amdgcn_sinf(rv)); }
    }
    { u32x4* z = (u32x4*)(ws + WS_WDOWN + (size_t)1088 * DM * 2); const int nz = (DOWNP - 1088) * DM * 2 / 16;
      for (int i = obid() * 512 + tid; i < nz; i += gridDim.x * 512) z[i] = (u32x4){0u, 0u, 0u, 0u}; }
    { u32x4* z0 = (u32x4*)(ws + WS_H - 4096); u32x4* z1 = (u32x4*)(ws + WS_H + (size_t)NROW * DM * 2); const int n1 = 384 * 256;
      for (int i = obid() * 512 + tid; i < 256 + n1; i += gridDim.x * 512) { if (i < 256) z0[i] = (u32x4){0u, 0u, 0u, 0u}; else z1[i - 256] = (u32x4){0u, 0u, 0u, 0u}; } }
    float* sl = (float*)(lds + 73728);
    for (int i = tid; i < 5 * DM; i += 512) { const int r = i / DM, k = i % DM; const float v = r < 4 ? p->in[1][r * DM + k] : p->in[3][k]; sl[i] = silu_f(v); }
    __syncthreads();
    for (int it = gw; it < 2 * KSPLIT * 48; it += NGW) {
        const int nb = it % 48, ks = (it / 48) % KSPLIT, l = it / (48 * KSPLIT);
        const float* W = p->in[4] + (size_t)l * DM * MOD6 + (size_t)(ks * 64) * MOD6 + nb * 256 + lane * 4;
        f32x4 acc[5];
#pragma unroll
        for (int r = 0; r < 5; ++r) acc[r] = (f32x4){0.f, 0.f, 0.f, 0.f};
#pragma unroll 8
        for (int k = 0; k < 64; ++k) { const f32x4 w = *(const f32x4*)(W + (size_t)k * MOD6);
#pragma unroll
            for (int r = 0; r < 5; ++r) acc[r] += w * sl[r * DM + ks * 64 + k]; }
        float* dst = (float*)(ws + WS_MODP) + ((size_t)(ks * 2 + l) * 5) * MOD6 + nb * 256 + lane * 4;
#pragma unroll
        for (int r = 0; r < 5; ++r) *(f32x4*)(dst + (size_t)r * MOD6) = acc[r];
    }
    __syncthreads();
    LAS float* scr = (LAS float*)(lds + wave * 16896);
    constexpr int I0 = 32 * 96, I1 = 32 * 32, I2 = 32 * 172, I4 = 86 * 32, I6 = 32 * 17, I7 = 8 * 48, I8 = 8 * 64, I9 = 32 * 32;
    constexpr int NIT = I0 + I1 + 2 * I2 + 2 * I4 + I6 + I7 + I8 + I9;
    for (int it = gw; it < NIT; it += NGW) {
        int r = it; const float* W; int K, N; bf16_t* WT; bool fmap = false; int emap = 0;
        if (r < I0) { W = p->in[11]; K = DM; N = EPROJ; WT = (bf16_t*)(ws + WS_WEIN); emap = 1; }
        else if ((r -= I0) < I1) { W = p->in[12]; K = DM; N = DM; WT = (bf16_t*)(ws + WS_WEOUT); }
        else if ((r -= I1) < 2 * I2) { const int l = r / I2; r -= l * I2; W = p->in[8] + (size_t)l * DM * DFF2; K = DM; N = DFF2; WT = (bf16_t*)(ws + WS_WFIN + l * WFIN_STRIDE); fmap = true; }
        else if ((r -= 2 * I2) < 2 * I4) { const int l = r / I4; r -= l * I4; W = p->in[10] + (size_t)l * DFF * DM; K = DFF; N = DM; WT = (bf16_t*)(ws + WS_WFOUT + l * WFOUT_STRIDE); }
        else if ((r -= 2 * I4) < I6) { W = p->in[20]; K = DM; N = 1088; WT = (bf16_t*)(ws + WS_WDOWN); emap = 3; }
        else if ((r -= I6) < I7) { W = p->in[23]; K = 512; N = QW; WT = (bf16_t*)(ws + WS_WUQ); emap = 2; }
        else if ((r -= I7) < I8) { W = p->in[24]; K = 512; N = KVW; WT = (bf16_t*)(ws + WS_WUKV); }
        else { r -= I8; W = p->in[29]; K = DM; N = DM; WT = (bf16_t*)(ws + WS_WMOUT); }
        const int nkb = K / 64, kb = r % nkb, nbi = r / nkb, n0 = nbi * 64;
        transpose_item(W, K, N, WT, fmap ? ffn_rowmap(n0) : n0, kb * 64, n0, scr, lane, emap);
    }
}

__device__ __forceinline__ void phase_adared(KPP p) {
    const float* mp = (const float*)(p->ws + WS_MODP); float* mod = (float*)(p->ws + WS_MOD);
    for (int i = obid() * 512 + otid(); i < 2 * 5 * MOD6; i += gridDim.x * 512) {
        const int n = i % MOD6, l = i / (5 * MOD6);
        float s = p->in[5][l * MOD6 + n];
        for (int ks = 0; ks < KSPLIT; ++ks) s += mp[(size_t)ks * (2 * 5 * MOD6) + i];
        mod[i] = s;
    }
}

__device__ __forceinline__ void phase_mod(KPP p, const void* src_lat, bool lat16, const float* src_ctx, int nrows, const float* gain, const float* modl, int shift_off, int scale_off, const float* pgate) {
    const int tid_ = otid(); const int lane = tid_ & 63, gw = obid() * 8 + (tid_ >> 6), NGW = gridDim.x * 8;
    bf16_t* H = (bf16_t*)(p->ws + WS_H);
    for (int row = gw; row < nrows; row += NGW) {
        const bool isctx = row >= NLAT; const int mr = isctx ? 4 : row / SEQ;
        const float* xr = isctx ? src_ctx + (size_t)(row - NLAT) * DM : (const float*)src_lat + (size_t)row * DM;
        const float* sh = modl + (size_t)mr * MOD6 + shift_off; const float* sc = modl + (size_t)mr * MOD6 + scale_off;
        f32x4 v[8]; float ss = 0.f;
        if (!isctx && lat16) { const bf16_t* xb = (const bf16_t*)src_lat + (size_t)row * DM;
#pragma unroll
            for (int j = 0; j < 8; ++j) { const u32x2 w = *(const u32x2*)(xb + j * 256 + lane * 4); v[j] = (f32x4){bflo(w.x), bfhi(w.x), bflo(w.y), bfhi(w.y)}; } }
        else {
#pragma unroll
            for (int j = 0; j < 8; ++j) v[j] = *(const f32x4*)(xr + j * 256 + lane * 4); }
        if (isctx && pgate) {
            const float* pp = (const float*)(p->ws + WS_PART) + (size_t)(row - NLAT) * DM; float* xo = (float*)(p->ws + WS_XC) + (size_t)(row - NLAT) * DM;
#pragma unroll
            for (int j = 0; j < 8; ++j) { const int c = j * 256 + lane * 4; f32x4 a = *(const f32x4*)(pp + c);
#pragma unroll
                for (int k = 1; k < 8; ++k) a += *(const f32x4*)(pp + (size_t)k * NCTX * DM + c);
                v[j] += *(const f32x4*)(pgate + c) * a; *(f32x4*)(xo + c) = v[j]; }
        }
#pragma unroll
        for (int j = 0; j < 8; ++j) ss += (v[j].x * v[j].x + v[j].y * v[j].y) + (v[j].z * v[j].z + v[j].w * v[j].w);
        const float rstd = rsqrtf(wave_sum(ss) * (1.f / DM) + EPS);
#pragma unroll
        for (int j = 0; j < 8; ++j) { const int c = j * 256 + lane * 4; const f32x4 g = *(const f32x4*)(gain + c), s1 = *(const f32x4*)(sc + c), s0 = *(const f32x4*)(sh + c);
            const f32x4 y = (v[j] * rstd * g) * (s1 + 1.f) + s0;
            u32x2 w; w.x = pk2(y.x, y.y); w.y = pk2(y.z, y.w); *(u32x2*)(H + (size_t)row * DM + c) = w; }
    }
}

__device__ __forceinline__ void phase_diffcomb(KPP p) {
    const int tid_ = otid(); const int lane = tid_ & 63, gw = obid() * 8 + (tid_ >> 6), NGW = gridDim.x * 8;
    const float* dl = p->in[18];
    float a = dl[lane] * dl[128 + lane] + dl[64 + lane] * dl[192 + lane], b = dl[256 + lane] * dl[384 + lane] + dl[320 + lane] * dl[448 + lane];
    const float lam_init = 0.2f;
    const float lam = __expf(wave_sum(a)) - __expf(wave_sum(b)) + lam_init;
    const bf16_t* P1 = (const bf16_t*)(p->ws + WS_DIFFP); const bf16_t* P2 = P1 + (size_t)NROW * 1024; bf16_t* O = (bf16_t*)(p->ws + WS_O);
    const float* sg = p->in[19] + (lane & 31) * 8;
    for (int it = gw; it < NROW * 2; it += NGW) {
        const int row = it >> 1, col = (it & 1) * 512 + lane * 8;
        float av[8], bv[8]; unpack8(*(const u32x4*)(P1 + (size_t)row * 1024 + col), av); unpack8(*(const u32x4*)(P2 + (size_t)row * 1024 + col), bv);
        const f32x4 d0 = (f32x4){av[0], av[1], av[2], av[3]} - (f32x4){bv[0], bv[1], bv[2], bv[3]} * lam, d1 = (f32x4){av[4], av[5], av[6], av[7]} - (f32x4){bv[4], bv[5], bv[6], bv[7]} * lam;
        float x[8] = {d0.x, d0.y, d0.z, d0.w, d1.x, d1.y, d1.z, d1.w}; float ss = 0.f;
#pragma unroll
        for (int e = 0; e < 8; ++e) ss += x[e] * x[e];
        const float rstd = rsqrtf(grp_sum<32>(ss) * (1.f / 256.f) + EPS) * (1.f - lam_init);
#pragma unroll
        for (int e = 0; e < 8; ++e) x[e] = x[e] * rstd * sg[e];
        *(u32x4*)(O + (size_t)row * DM + 1024 + col) = pack8(x);
    }
}

__device__ __forceinline__ void phase_att0(KPP p, char* lds) {
    const bf16_t* QKV = (const bf16_t*)(p->ws + WS_QKV); bf16_t* O = (bf16_t*)(p->ws + WS_O); bf16_t* DP = (bf16_t*)(p->ws + WS_DIFFP);
    constexpr int NU_DIFF = NB * 4 * 2 * 2 * 16, NU_NA = NB * 8 * 16, NU_CNA = NB * 8, NU_CDIFF = NB * 4 * 2 * 2;
    const int bx_ = obid(), vcu = (gridDim.x % 8 == 0) ? (bx_ % 8) * (gridDim.x / 8) + bx_ / 8 : bx_;
    for (int ui = vcu; ui < NU_DIFF + NU_NA + NU_CNA + NU_CDIFF; ui += gridDim.x) {
        att::AUnit u; u.ldq = EPROJ; u.ldk = EPROJ; u.KR = nullptr; u.qrow0 = 0; u.krow0 = 0; u.qroff = 0;
        if (ui < NU_DIFF || ui >= NU_DIFF + NU_NA + NU_CNA) {
            const bool cx = ui >= NU_DIFF; const int v = cx ? ui - (NU_DIFF + NU_NA + NU_CNA) : ui;
            const int qb = cx ? 0 : (v & 15), rest = cx ? v : (v >> 4), vh = rest & 1, half = (rest >> 1) & 1, h = (rest >> 2) & 3, b = rest >> 4;
            const int qrow = cx ? NLAT + b * CTXL : b * SEQ + qb * 256;
            u.Q = QKV + (size_t)qrow * EPROJ + 3072 + (2 * h + half) * 128;
            u.K = QKV + 4096 + (2 * h + half) * 128; u.V = QKV + 5120 + h * 256 + vh * 128;
            if (cx) { u.base0 = NLAT + b * CTXL; u.n0 = 4; u.base1 = 0; u.NT = 4; } else { u.base0 = b * SEQ; u.n0 = 64; u.base1 = NLAT + b * CTXL; u.NT = 68; }
            u.O = DP + (size_t)half * NROW * 1024 + (size_t)qrow * 1024 + h * 256 + vh * 128; u.ldo = 1024;
            att::attn_unit<0, false>(u, lds);
        } else if (ui < NU_DIFF + NU_NA) {
            const int v = ui - NU_DIFF, qb = v & 15, h = (v >> 4) & 7, b = v >> 7;
            const int qrow = b * SEQ + qb * 256, r0 = qb * 4, lo = min(max(r0 - 4, 0), 52);
            {
                float* tab = (float*)(lds + att::OFF_TAB); const float* rp = p->in[15] + h * 465;
                for (int i = otid(); i < 465; i += 512) tab[i] = rp[i] * 11.313708498984761f;
            }
            u.Q = QKV + (size_t)qrow * EPROJ + h * 128; u.K = QKV + 1024 + h * 128; u.V = QKV + 2048 + h * 128;
            u.base0 = b * SEQ + lo * 64; u.n0 = 12; u.base1 = NLAT + b * CTXL; u.NT = 16; u.qrow0 = r0; u.krow0 = lo;
            u.O = O + (size_t)qrow * DM + h * 128; u.ldo = DM;
            att::attn_unit<1, false>(u, lds);
        } else {
            const int v = ui - NU_DIFF - NU_NA, h = v & 7, b = v >> 3; const int qrow = NLAT + b * CTXL;
            u.Q = QKV + (size_t)qrow * EPROJ + h * 128; u.K = QKV + 1024 + h * 128; u.V = QKV + 2048 + h * 128;
            u.base0 = qrow; u.n0 = 4; u.base1 = 0; u.NT = 4;
            u.O = O + (size_t)qrow * DM + h * 128; u.ldo = DM;
            att::attn_unit<0, false>(u, lds);
        }
    }
}
__device__ __forceinline__ void phase_att1(KPP p, char* lds) {
    const bf16_t* Q1 = (const bf16_t*)(p->ws + WS_Q1); const bf16_t* KV1 = (const bf16_t*)(p->ws + WS_KV1); bf16_t* O = (bf16_t*)(p->ws + WS_O1);
    const int bx_ = obid(), vcu = (gridDim.x % 8 == 0) ? (bx_ % 8) * (gridDim.x / 8) + bx_ / 8 : bx_;
    for (int ui = vcu; ui < NB * 16 * 16; ui += gridDim.x) {
        const int qb = ui & 15, h = (ui >> 4) & 15, b = ui >> 8; const int qrow = b * SEQ + qb * 256;
        att::AUnit u; u.ldq = QW; u.ldk = KVW; u.KR = (const bf16_t*)(p->ws + WS_KROPE); u.qrow0 = 0; u.krow0 = 0;
        u.Q = Q1 + (size_t)qrow * QW + h * 128; u.qroff = 2048 - h * 64; u.K = KV1 + h * 256; u.V = KV1 + h * 256 + 128;
        u.base0 = b * SEQ; u.n0 = 64; u.base1 = NLAT + b * CTXL; u.NT = 68;
        u.O = O + (size_t)qrow * DM + h * 128; u.ldo = DM;
        att::attn_unit<2, false>(u, lds);
    }
}

#define XB_TMO      128
#define XB_XCNT(j)  (256  + 64 * (j))
#define XB_XSUB(j)  (1280 + 64 * (j))
#define XB_XGEN(j)  (2304 + 64 * (j))
#define XB_TOP      3328
#define XB_TOPGEN   3392
#define XCD_BAR_WORDS 3456
#define XB_SPIN_CAP (1u << 18)

__device__ __forceinline__ unsigned xb_ld(unsigned* p)              { return __hip_atomic_load(p, __ATOMIC_RELAXED, __HIP_MEMORY_SCOPE_AGENT); }
__device__ __forceinline__ unsigned xb_add(unsigned* p, unsigned v) { return __hip_atomic_fetch_add(p, v, __ATOMIC_RELAXED, __HIP_MEMORY_SCOPE_AGENT); }
__device__ __forceinline__ unsigned xb_xcc_id() { return (unsigned)__builtin_amdgcn_s_getreg((3 << 11) | 20) & 0xFu; }
#define XB_SPIN(cond, bar) do { unsigned _sp = 0; while (cond) { __builtin_amdgcn_s_sleep(1); \
    if ((++_sp & 255u) == 0u) { if (xb_ld(&(bar)[XB_TMO])) break; if (_sp > XB_SPIN_CAP) { atomicAdd(&(bar)[XB_TMO], 1u); break; } } } } while (0)

struct XcdBarrier {
    unsigned* bar; unsigned x;
    volatile LAS unsigned* st;
};

__device__ __forceinline__ XcdBarrier xcd_barrier_post(unsigned* bar, volatile LAS unsigned* st) {
    XcdBarrier b; b.bar = bar; b.x = xb_xcc_id(); b.st = st;
    if (threadIdx.x == 0) (void)xb_add(&bar[XB_XCNT(b.x)], 1u);
    return b;
}
__device__ __forceinline__ void xcd_barrier_complete(unsigned* bar, unsigned x, unsigned& nloc, unsigned& nx) {
    const unsigned G = gridDim.x * gridDim.y * gridDim.z;
    unsigned sum, cnt, mine, sp = 0u;
    for (;;) {
        sum = 0u; cnt = 0u; mine = 0u;
#pragma unroll
        for (unsigned j = 0; j < 16; ++j) { const unsigned c = xb_ld(&bar[XB_XCNT(j)]); sum += c; cnt += (c > 0u) ? 1u : 0u; mine = (j == x) ? c : mine; }
        if (sum == G) break;
        __builtin_amdgcn_s_sleep(1);
        if ((++sp & 255u) == 0u) { if (xb_ld(&bar[XB_TMO])) break; if (sp > XB_SPIN_CAP) { atomicAdd(&bar[XB_TMO], 1u); break; } }
    }
    nloc = mine > 0u ? mine : 1u; nx = cnt > 0u ? cnt : 1u;
}

__device__ __forceinline__ void xcd_barrier(const XcdBarrier& b) {
    asm volatile("s_waitcnt vmcnt(0)" ::: "memory");
    __syncthreads();
    if (threadIdx.x == 0) {
        unsigned* bar = b.bar;
        __builtin_amdgcn_s_waitcnt(0);
        unsigned nloc = b.st[0], nx = b.st[1];
        if (nloc == 0u) { xcd_barrier_complete(bar, b.x, nloc, nx); b.st[0] = nloc; b.st[1] = nx; }
        const unsigned old = xb_add(&bar[XB_XSUB(b.x)], 1u);
        const unsigned gen = old / nloc;
        if (old + 1u == (gen + 1u) * nloc) {
            __builtin_amdgcn_fence(__ATOMIC_RELEASE, "agent");
            asm volatile("s_waitcnt vmcnt(0)" ::: "memory");
            const unsigned og = xb_add(&bar[XB_TOP], 1u);
            const unsigned tg = og / nx;
            if (og + 1u == (tg + 1u) * nx) xb_add(&bar[XB_TOPGEN], 1u);
            else XB_SPIN(xb_ld(&bar[XB_TOPGEN]) == tg, bar);
            __builtin_amdgcn_fence(__ATOMIC_ACQUIRE, "agent");
            xb_add(&bar[XB_XGEN(b.x)], 1u);
            asm volatile("s_waitcnt vmcnt(0)" ::: "memory");
        } else {
            XB_SPIN(xb_ld(&bar[XB_XGEN(b.x)]) == gen, bar);
            __builtin_amdgcn_fence(__ATOMIC_ACQUIRE, "agent");
            asm volatile("s_waitcnt vmcnt(0)" ::: "memory");
        }
    }
    __syncthreads();
}

enum { K_PRO, K_ADARED, K_MOD, K_GEMM_BF16, K_GEMM_F32, K_GEMM_RES, K_QKNORM, K_ATT0, K_DIFFCOMB, K_CONV, K_POSTDOWN, K_POSTUP, K_ATT1, K_GEMM_CONV, K_GEMM_QK, K_GEMM_Q1, K_GEMM_KV, K_GEMM_DOWN };
constexpr int NPH = 19;

__global__ void __launch_bounds__(512, 2) mk_fwd(KP p_unused) {
    extern __shared__ __attribute__((aligned(16))) unsigned char lds[];
    const int G = gridDim.x;
    volatile LAS unsigned* bst = (volatile LAS unsigned*)((LAS unsigned char*)lds + (LDS_BYTES - 256));
    if (threadIdx.x < 4) bst[threadIdx.x] = 0u;
    __syncthreads();
    XcdBarrier gbar; gbar.bar = nullptr; gbar.x = 0; gbar.st = nullptr;
#if ONE_LAUNCH
    gbar = xcd_barrier_post((unsigned*)(((KPP)__builtin_amdgcn_kernarg_segment_ptr())->ws), bst);
#endif
    const int ph_lo = ((KPP)__builtin_amdgcn_kernarg_segment_ptr())->ph_lo, ph_hi = ((KPP)__builtin_amdgcn_kernarg_segment_ptr())->ph_hi;
    for (int ph = ph_lo; ph < ph_hi; ++ph) {
        KPP p = (KPP)__builtin_amdgcn_kernarg_segment_ptr(); asm volatile("" : "+s"(p));
        unsigned char* ws = p->ws;
        float* XC = (float*)(ws + WS_XC); const float* MOD = (const float*)(ws + WS_MOD);
        const bf16_t* H = (const bf16_t*)(ws + WS_H);
        int kind = K_PRO, layer = ph >= 10 ? 1 : 0; bool nosync = false;
        const bf16_t* gA = H; const bf16_t* gB = nullptr; int gM = NROW, gN = 0, gK = DM; void* gO = nullptr; int gld = 0;
        const void* rs_lat = ws + WS_XB; void* rd_lat = ws + WS_XB; bool rs16 = true, rd16 = true; const float* rs_ctx = XC; int gate_off = 0;
        const void* m_lat = ws + WS_XB; bool m16 = true; const float* m_ctx = XC; int m_rows = NROW; const float* m_gain = nullptr; int m_sh = 0, m_sc = 0; const float* m_pg = nullptr;
        switch (ph) {
            case 0: kind = K_PRO; break;
            case 1: kind = K_ADARED; break;
            case 2: kind = K_MOD; m_lat = p->in[0]; m16 = false; m_ctx = p->in[2]; m_gain = p->in[6]; m_sh = 0; m_sc = 2048; break;
            case 3: kind = K_GEMM_QK; gB = (const bf16_t*)(ws + WS_WEIN); gN = EPROJ; break;
            case 4: kind = K_ATT0; break;
            case 5: kind = K_DIFFCOMB; break;
            case 6: kind = K_GEMM_RES; gA = (const bf16_t*)(ws + WS_O); gB = (const bf16_t*)(ws + WS_WEOUT); gN = DM; rs_lat = p->in[0]; rs16 = false; rs_ctx = p->in[2]; gate_off = 4096; break;
            case 7: kind = K_MOD; m_gain = p->in[7]; m_sh = 6144; m_sc = 8192; m_ctx = p->in[2]; m_pg = MOD + 4 * MOD6 + 4096; break;
            case 8: case 17: kind = K_GEMM_CONV; gB = (const bf16_t*)(ws + WS_WFIN + layer * WFIN_STRIDE); gM = layer ? NLAT : NROW; break;
            case 9: case 18: kind = K_GEMM_RES; gA = (const bf16_t*)(ws + WS_ACT); gB = (const bf16_t*)(ws + WS_WFOUT + layer * WFOUT_STRIDE); gN = DM; gK = DFF; gate_off = 10240; gM = layer ? NLAT : NROW; if (layer) { rd_lat = p->out; rd16 = false; } break;
            case 10: kind = K_MOD; m_gain = p->in[6] + DM; m_sh = 0; m_sc = 2048; m_pg = MOD + 4 * MOD6 + 10240; break;
            case 11: kind = K_GEMM_DOWN; gB = (const bf16_t*)(ws + WS_WDOWN); gN = DOWNP; break;
            case 12: kind = K_GEMM_Q1; gA = (const bf16_t*)(ws + WS_QLAT); gB = (const bf16_t*)(ws + WS_WUQ); gM = NLAT; gN = QW; gK = 512; nosync = true; break;
            case 13: kind = K_GEMM_KV; gA = (const bf16_t*)(ws + WS_KVLAT); gB = (const bf16_t*)(ws + WS_WUKV); gN = KVW; gK = 512; break;
            case 14: kind = K_ATT1; break;
            case 15: kind = K_GEMM_RES; gA = (const bf16_t*)(ws + WS_O1); gB = (const bf16_t*)(ws + WS_WMOUT); gM = NLAT; gN = DM; gate_off = 4096; break;
            case 16: kind = K_MOD; m_rows = NLAT; m_gain = p->in[7] + DM; m_sh = 6144; m_sc = 8192; break;
            default: break;
        }
        const float* modl = MOD + (size_t)layer * 5 * MOD6;
        int rep = 1;
#if PROBE & 1
        if (kind == K_ATT0 || kind == K_ATT1) rep = 2;
#endif
#if PROBE & 2
        if (kind == K_GEMM_BF16 || kind == K_GEMM_DOWN || kind == K_GEMM_CONV || kind == K_GEMM_QK || kind == K_GEMM_Q1 || kind == K_GEMM_KV) rep = 2;
#endif
#if PROBE & 4
        if (kind == K_PRO) rep = 2;
#endif
#if PROBE & 8
        if (kind == K_MOD || kind == K_DIFFCOMB) rep = 2;
#endif
        for (int rp = 0; rp < rep; ++rp) {
        if (rp) xcd_barrier(gbar);
        switch (kind) {
            case K_PRO:
#ifndef DIS_PRO
 phase_prologue(p, lds);
#endif
 break;
            case K_ADARED: phase_adared(p); break;
            case K_MOD: phase_mod(p, m_lat, m16, m_ctx, m_rows, m_gain, modl, m_sh, m_sc, m_pg); break;
            #ifndef DIS_GEMM
            case K_GEMM_BF16: { pg8::Gemm g{gA, gB, gM, gN, gK}; pg8::StaticOrder S; S.init(gM, gN, G, obid());
                pg8::EpiBf16<0> E{(bf16_t*)gO, gld, nullptr, 0, 0, 1.f};
                pg8::gemm_phase<pg8::EpiBf16<0>, pg8::StaticOrder, true, true>((PG8_LAS unsigned char*)lds, g, S, E); } break;
            case K_GEMM_CONV: { const int ntm = (gM + 253) / 254; pg8::Gemm g{H - DM, gB, ntm * 256, DFF2, DM, 254}; pg8::StaticOrder S; S.init(ntm * 256, DFF2, G, obid());
                EpiConv E{(bf16_t*)(ws + WS_ACT), p->in[9] + (size_t)layer * 3 * DFF2, gM, (LAS float*)((LAS unsigned char*)lds + 131072)};
                pg8::gemm_phase<EpiConv, pg8::StaticOrder, true, true>((PG8_LAS unsigned char*)lds, g, S, E); } break;
            case K_GEMM_QK: { pg8::Gemm g{gA, gB, gM, gN, gK}; pg8::StaticOrder S; S.init(gM, gN, G, obid());
                EpiQK E{(bf16_t*)(ws + WS_QKV), (const float*)(ws + WS_GAINS), (LAS float*)((LAS unsigned char*)lds + 131072)};
                pg8::gemm_phase<EpiQK, pg8::StaticOrder, true, true>((PG8_LAS unsigned char*)lds, g, S, E); } break;
            case K_GEMM_Q1: { pg8::Gemm g{gA, gB, gM, gN, gK}; pg8::StaticOrder S; S.init(gM, gN, G, obid());
                EpiQ1 E{(bf16_t*)(ws + WS_Q1), p->in[25], p->in[26], (LAS float*)((LAS unsigned char*)lds + 131072), (const float*)(ws + WS_SSQ)};
                pg8::gemm_phase<EpiQ1, pg8::StaticOrder, true, true>((PG8_LAS unsigned char*)lds, g, S, E); } break;
            case K_GEMM_KV: { pg8::Gemm g{gA, gB, gM, gN, gK}; pg8::StaticOrder S; S.init(gM, gN, G, obid());
                EpiKV E{(bf16_t*)(ws + WS_KV1), p->in[27], (LAS float*)((LAS unsigned char*)lds + 131072), (const float*)(ws + WS_SSKV)};
                pg8::gemm_phase<EpiKV, pg8::StaticOrder, true, true>((PG8_LAS unsigned char*)lds, g, S, E); } break;
            case K_GEMM_DOWN: { pg8::Gemm g{gA, gB, gM, gN, gK}; pg8::StaticOrder S; S.init(gM, gN, G, obid());
                EpiDown E{(bf16_t*)(ws + WS_QLAT), (bf16_t*)(ws + WS_KVLAT), (bf16_t*)(ws + WS_KROPE), (float*)(ws + WS_SSKV), (float*)(ws + WS_SSQ), p->in[21], p->in[22], p->in[28], (LAS float*)((LAS unsigned char*)lds + 131072)};
                pg8::gemm_phase<EpiDown, pg8::StaticOrder, true, true>((PG8_LAS unsigned char*)lds, g, S, E); } break;
            case K_GEMM_RES: { pg8::Gemm g{gA, gB, gM, gN, gK}; SplitOrder S; S.init(gN, gK, G, obid(), gM > NLAT);
                EpiRes E{rs_lat, rd_lat, modl, gate_off, (float*)(ws + WS_PART), rs16, rd16};
                pg8::gemm_phase<EpiRes, SplitOrder, true, true>((PG8_LAS unsigned char*)lds, g, S, E); } break;
#endif
            case K_ATT0:
#ifndef DIS_ATT0
 phase_att0(p, (char*)lds);
#endif
 break;
            case K_DIFFCOMB:
#ifndef DIS_EW
 phase_diffcomb(p);
#endif
 break;
            case K_ATT1:
#ifndef DIS_ATT1
 phase_att1(p, (char*)lds);
#endif
 break;
        }
        }
#if PROBE & 16
        if (ph + 1 < ph_hi) xcd_barrier(gbar);
#endif
        if (ph + 1 < ph_hi) { if (nosync) __syncthreads(); else if (ph_hi > 4096) cg::this_grid().sync(); else xcd_barrier(gbar); }
    }
}

extern "C" void kernel_launch(void* const* d_in, const int* in_sizes, int n_in, void* d_out, int out_size, void* d_ws, size_t ws_size, hipStream_t stream) {
    static int grid = 0;
    if (grid == 0) {
        if (n_in != 30 || ws_size < WS_END) { fprintf(stderr, "kernel_launch: n_in %d ws %zu (need %zu)\n", n_in, ws_size, (size_t)WS_END); grid = -1; return; }
        int dev = 0, cus = 0, per_cu = 0;
        hipGetDevice(&dev); hipDeviceGetAttribute(&cus, hipDeviceAttributeMultiprocessorCount, dev);
        hipFuncSetAttribute((const void*)mk_fwd, hipFuncAttributeMaxDynamicSharedMemorySize, LDS_BYTES);
        hipOccupancyMaxActiveBlocksPerMultiprocessor(&per_cu, (const void*)mk_fwd, 512, LDS_BYTES);
        (void)hipGetLastError();
        if (per_cu < 1) per_cu = 1;
        grid = cus;
    }
    if (grid < 0) return;
    hipMemsetAsync(d_ws, 0, 16384, stream);
    KP a{};
    for (int i = 0; i < 30; ++i) a.in[i] = (const float*)d_in[i];
    a.out = (float*)d_out; a.ws = (unsigned char*)d_ws;
#if ONE_LAUNCH
    a.ph_lo = 0; a.ph_hi = NPH;
    void* args[] = {&a};
    hipError_t e = hipLaunchCooperativeKernel((const void*)mk_fwd, dim3(grid), dim3(512), args, LDS_BYTES, stream);
    if (e != hipSuccess) fprintf(stderr, "cooperative launch failed: %s (grid %d)\n", hipGetErrorString(e), grid);
#else
    for (int ph = 0; ph < NPH; ++ph) { a.ph_lo = ph; a.ph_hi = ph + 1; hipLaunchKernelGGL(mk_fwd, dim3(grid), dim3(512), LDS_BYTES, stream, a); }
#endif
}
```

```cpp
#include <hip/hip_runtime.h>
#include <hip/hip_cooperative_groups.h>
#include <cstdio>
#include <cstdint>
namespace cg = cooperative_groups;
namespace pg8 {
#define PG8_LAS __attribute__((address_space(3)))
typedef unsigned short bf16_t;
typedef short bf16x8 __attribute__((ext_vector_type(8)));
typedef float f32x4 __attribute__((ext_vector_type(4)));
typedef unsigned u32x4 __attribute__((ext_vector_type(4)));
constexpr int BM = 256, BK = 64, HALF = 128, HTB = HALF * BK * 2  , STAGE_BYTES = 8 * HTB, NXCD = 8, WGM = 4;

__host__ __device__ __forceinline__ int lds_byte(int r, int c) { const int st = (r >> 4) * 2 + (c >> 5), rr = r & 15, cc = c & 31, ob = rr * 64 + cc * 2; return st * 1024 + (ob ^ (((ob >> 9) & 1) << 5)); }
__host__ __device__ __forceinline__ void stage_rc(int b, int& R, int& C) { const int st = b / 1024, sb = b % 1024, swz = sb ^ (((sb >> 9) & 1) << 5); R = (st >> 1) * 16 + swz / 64; C = (st & 1) * 32 + (swz % 64) / 2; }
__host__ __device__ __forceinline__ int perm32(int rho) { const int n = rho >> 4, i = rho & 15; return 8 * (i >> 2) + 4 * n + (i & 3); }

struct Unit { int pm, pn; int k0 = 0, nt = 0, ks = -1; };
struct Gemm { const bf16_t* A; const bf16_t* Bt; int M, N, K; int astep = 256; };

struct StaticOrder {
    int nM, nN, nwg, G, c;
    __host__ __device__ void init(int M, int N, int G_, int c_) { nM = M / BM; nN = N / BM; nwg = nM * nN; G = G_; c = c_; }
    __host__ __device__ bool next(int i, Unit& u) const {
        const long L = (long)i * G + c; if (L >= nwg) return false;
        int wgid = (int)L; { const int q = nwg / NXCD, r = nwg % NXCD, xcd = wgid % NXCD, off = wgid / NXCD; wgid = (xcd < r ? xcd * (q + 1) : r * (q + 1) + (xcd - r) * q) + off; }
        const int nig = WGM * nN, gid = wgid / nig, fm = gid * WGM, gsz = (nM - fm) < WGM ? (nM - fm) : WGM;
        u.pm = fm + ((wgid % nig) % gsz); u.pn = (wgid % nig) / gsz; return true;
    }
    __device__ __forceinline__ void a_ready(const Unit&) const {}
    __device__ __forceinline__ void done(const Unit&) const {}
};

__device__ __forceinline__ unsigned cvt_pk_bf16(float lo, float hi) { unsigned r; asm volatile("v_cvt_pk_bf16_f32 %0, %1, %2" : "=v"(r) : "v"(lo), "v"(hi)); return r; }
typedef float f32x2 __attribute__((ext_vector_type(2)));
__device__ __forceinline__ f32x2 gelu_pk(f32x2 v) {
    const f32x2 av = __builtin_elementwise_abs(v), d = av * 0.2316418882f + 1.0f;
    f32x2 t; t.x = __builtin_amdgcn_rcpf(d.x); t.y = __builtin_amdgcn_rcpf(d.y);
    f32x2 q = t * 0.5307027145f + (-0.7265760135f); q = q * t + 0.7107068705f; q = q * t + (-0.142248368f); q = q * t + 0.127414796f; q = q * t;
    const f32x2 s = (v * v) * (-0.72134752044f);
    f32x2 e; e.x = __builtin_amdgcn_exp2f(s.x); e.y = __builtin_amdgcn_exp2f(s.y);
    const f32x2 m = v * (q * e), r = v - m;
    f32x2 o; o.x = v.x < 0.f ? m.x : r.x; o.y = v.y < 0.f ? m.y : r.y; return o;
}

template <int ACT  > struct EpiBf16 {
    static constexpr bool PERM = true, AFTER_DRAIN = false; static_assert(ACT == 0 || ACT == 1, "EpiBf16: ACT is 0 (none) or 1 (gelu_pk)");
    bf16_t* O; int ldc; const float* bias; int split_cols; size_t split_stride; float scale0;
    __device__ __forceinline__ void operator()(const f32x4 (&acc)[2][2][4][2], const Unit& u, int wr, int wc, int fr, int fq) const {
        const int row0 = u.pm * BM + wr * 64 + fr; int colt = u.pn * BM; bf16_t* base = O;
        float sc = 1.f; if (split_cols) { const int t = colt / split_cols; base += (size_t)t * split_stride; colt -= t * split_cols; if (t == 0) sc = scale0; }
        const int col0 = colt + wc * 32 + 8 * fq, bcol0 = u.pn * BM + wc * 32 + 8 * fq;
        f32x4 bv[2][2];
#pragma unroll
        for (int bj = 0; bj < 2; ++bj)
#pragma unroll
            for (int n = 0; n < 2; ++n) bv[bj][n] = bias ? *(const f32x4*)(bias + bcol0 + bj * HALF + 4 * n) : (f32x4){0.f, 0.f, 0.f, 0.f};
#pragma unroll
        for (int ai = 0; ai < 2; ++ai)
#pragma unroll
            for (int m = 0; m < 4; ++m) { bf16_t* rowp = base + (size_t)(row0 + ai * HALF + m * 16) * ldc + col0;
#pragma unroll
                for (int bj = 0; bj < 2; ++bj) { f32x4 v0 = acc[ai][bj][m][0] + bv[bj][0], v1 = acc[ai][bj][m][1] + bv[bj][1];
                    if (ACT == 1) { f32x2 a = gelu_pk((f32x2){v0[0], v0[1]}), b = gelu_pk((f32x2){v0[2], v0[3]}), c = gelu_pk((f32x2){v1[0], v1[1]}), d = gelu_pk((f32x2){v1[2], v1[3]});
                        v0 = (f32x4){a.x, a.y, b.x, b.y}; v1 = (f32x4){c.x, c.y, d.x, d.y}; }
                    v0 = v0 * sc; v1 = v1 * sc; u32x4 w; w.x = cvt_pk_bf16(v0[0], v0[1]); w.y = cvt_pk_bf16(v0[2], v0[3]); w.z = cvt_pk_bf16(v1[0], v1[1]); w.w = cvt_pk_bf16(v1[2], v1[3]);
                    *(u32x4*)(rowp + bj * HALF) = w; } }
    }
};
template <class Epi, class Sched, bool ALIGN_EPI = false, bool SP2 = false>
__device__ __forceinline__ void gemm_phase(PG8_LAS unsigned char* lds, const Gemm g, const Sched& S, const Epi& E) {
    int tid_o = threadIdx.x; asm volatile("" : "+v"(tid_o)); const int tid = tid_o, wid = __builtin_amdgcn_readfirstlane(tid >> 6), lane = tid & 63, wr = wid >> 2, wc = wid & 3, fr = lane & 15, fq = lane >> 4;
    const int K = g.K, nt = K / BK;
    unsigned voffA[2], voffB[2];
#pragma unroll
    for (int i = 0; i < 2; ++i) { int R, C; stage_rc(tid * 16 + i * 8192, R, C); const int Rb = Epi::PERM ? ((R & ~31) + perm32(R & 31)) : R;
        voffA[i] = (unsigned)(R * K + C) * 2u; voffB[i] = (unsigned)(Rb * K + C) * 2u; }
    const size_t kstep = (size_t)(BK * 2);
    const size_t hstep = (size_t)HALF * K * 2;
    const size_t tstep = 2 * hstep;
    const unsigned ldsw = (unsigned)wid * 1024u;
    const int aoff = lds_byte(wr * 64 + fr, fq * 8), boff = lds_byte(wc * 32 + fr, fq * 8);
#define PG8_SA(b, h) (((b) * 2 + (h)) * HTB)
#define PG8_SB(b, h) ((4 + (b) * 2 + (h)) * HTB)
#define PG8_STAGE(bufoff, gbase, voff) do { _Pragma("unroll") for (int _i = 0; _i < 2; ++_i) \
        __builtin_amdgcn_global_load_lds((const unsigned*)((const char*)(gbase) + (voff)[_i]), (PG8_LAS unsigned*)(lds + (bufoff) + ldsw + _i * 8192), 16, 0, 0); } while (0)
#define PG8_LDA(dst, b, h) do { _Pragma("unroll") for (int m = 0; m < 4; ++m) _Pragma("unroll") for (int k = 0; k < 2; ++k) dst[m][k] = *(const PG8_LAS bf16x8*)(lds + PG8_SA(b, h) + aoff + m * 2048 + k * 1024); } while (0)
#define PG8_LDB(dst, b, h) do { _Pragma("unroll") for (int n = 0; n < 2; ++n) _Pragma("unroll") for (int k = 0; k < 2; ++k) dst[n][k] = *(const PG8_LAS bf16x8*)(lds + PG8_SB(b, h) + boff + n * 2048 + k * 1024); } while (0)
#define PG8_MMA(ai, bj, At, Bt) do { __builtin_amdgcn_s_setprio(1); _Pragma("unroll") for (int m = 0; m < 4; ++m) _Pragma("unroll") for (int n = 0; n < 2; ++n) _Pragma("unroll") for (int k = 0; k < 2; ++k) \
        acc[ai][bj][m][n] = __builtin_amdgcn_mfma_f32_16x16x32_bf16(Bt[n][k], At[m][k], acc[ai][bj][m][n], 0, 0, 0); __builtin_amdgcn_s_setprio(0); } while (0)
#define PG8_WAIT_V(n) asm volatile("s_waitcnt vmcnt(" #n ")" ::: "memory")
#define PG8_WAIT_L(n) asm volatile("s_waitcnt lgkmcnt(" #n ")" ::: "memory")
#define PG8_BAR __builtin_amdgcn_s_barrier()
#define PG8_SCHED __builtin_amdgcn_sched_barrier(0)
    Unit cur, nxt; int ui = 0;
    if (!S.next(0, cur)) return;
    f32x4 acc[2][2][4][2];
#pragma unroll
    for (int a = 0; a < 2; ++a)
#pragma unroll
        for (int b = 0; b < 2; ++b)
#pragma unroll
            for (int m = 0; m < 4; ++m)
#pragma unroll
                for (int n = 0; n < 2; ++n) acc[a][b][m][n] = (f32x4){0.f, 0.f, 0.f, 0.f};
    bf16x8 At[4][2], B0[2][2], B1[2][2];
    const size_t tstepA = (size_t)g.astep * K * 2; const char* cA = (const char*)g.A + (size_t)cur.pm * tstepA + (size_t)cur.k0 * kstep; const char* cB = (const char*)g.Bt + (size_t)cur.pn * tstep + (size_t)cur.k0 * kstep;
    S.a_ready(cur);
    if constexpr (SP2) {
        PG8_STAGE(PG8_SB(0, 0), cB, voffB); PG8_STAGE(PG8_SB(0, 1), cB + hstep, voffB); PG8_STAGE(PG8_SA(0, 0), cA, voffA); PG8_STAGE(PG8_SA(0, 1), cA + hstep, voffA);
        if (wr == 1) PG8_BAR;
        PG8_WAIT_V(2); PG8_BAR;
        PG8_STAGE(PG8_SB(1, 0), cB + kstep, voffB); PG8_STAGE(PG8_SA(1, 0), cA + kstep, voffA); PG8_STAGE(PG8_SB(1, 1), cB + hstep + kstep, voffB);
        PG8_WAIT_V(6); PG8_BAR;
    } else {
        PG8_STAGE(PG8_SB(0, 0), cB, voffB); PG8_STAGE(PG8_SA(0, 0), cA, voffA); PG8_STAGE(PG8_SB(0, 1), cB + hstep, voffB); PG8_STAGE(PG8_SA(0, 1), cA + hstep, voffA);
        if (wr == 1) PG8_BAR;
        PG8_WAIT_V(4); PG8_BAR;
        PG8_STAGE(PG8_SB(1, 0), cB + kstep, voffB); PG8_STAGE(PG8_SA(1, 0), cA + kstep, voffA); PG8_STAGE(PG8_SB(1, 1), cB + hstep + kstep, voffB);
        PG8_WAIT_V(6); PG8_BAR;
    }
    for (;;) {
        const bool has_next = S.next(ui + 1, nxt);
        const char* nA = has_next ? (const char*)g.A + (size_t)nxt.pm * tstepA + (size_t)nxt.k0 * kstep : cA; const char* nB = has_next ? (const char*)g.Bt + (size_t)nxt.pn * tstep + (size_t)nxt.k0 * kstep : cB;
        const int cnt = cur.nt ? cur.nt : nt;
        for (int t = 0; t < cnt; t += 2) {
            const bool last = (t == cnt - 2);
            const char* a1 = cA + (size_t)(t + 1) * kstep;
            const char* a2 = last ? nA : cA + (size_t)(t + 2) * kstep; const char* b2 = last ? nB : cB + (size_t)(t + 2) * kstep;
            const char* a3 = a2 + kstep; const char* b3 = b2 + kstep;
            if (last && has_next) S.a_ready(nxt);
            if constexpr (SP2) {
            PG8_LDB(B0, 0, 0); PG8_LDB(B1, 0, 1); PG8_SCHED; PG8_LDA(At, 0, 0); PG8_STAGE(PG8_SA(1, 1), a1 + hstep, voffA);
            PG8_WAIT_V(8); PG8_WAIT_L(0); PG8_BAR; PG8_MMA(0, 0, At, B0); PG8_MMA(0, 1, At, B1); PG8_BAR; PG8_SCHED;
            PG8_LDA(At, 0, 1); PG8_STAGE(PG8_SB(0, 0), b2, voffB); PG8_STAGE(PG8_SB(0, 1), b2 + hstep, voffB); PG8_STAGE(PG8_SA(0, 0), a2, voffA);
            PG8_WAIT_V(8); PG8_WAIT_L(0); PG8_BAR; PG8_MMA(1, 0, At, B0); PG8_MMA(1, 1, At, B1); PG8_BAR; PG8_SCHED;
            PG8_LDB(B0, 1, 0); PG8_LDB(B1, 1, 1); PG8_SCHED; PG8_LDA(At, 1, 0); PG8_STAGE(PG8_SA(0, 1), a2 + hstep, voffA);
            PG8_WAIT_V(8); PG8_WAIT_L(0); PG8_BAR; PG8_MMA(0, 0, At, B0); PG8_MMA(0, 1, At, B1); PG8_BAR; PG8_SCHED;
            PG8_LDA(At, 1, 1); PG8_STAGE(PG8_SB(1, 0), b3, voffB); PG8_STAGE(PG8_SB(1, 1), b3 + hstep, voffB); PG8_STAGE(PG8_SA(1, 0), a3, voffA);
            PG8_WAIT_V(8); PG8_WAIT_L(0); PG8_BAR; PG8_MMA(1, 0, At, B0); PG8_MMA(1, 1, At, B1); PG8_BAR; PG8_SCHED;
            } else {
            PG8_LDB(B0, 0, 0); PG8_SCHED; PG8_LDA(At, 0, 0); PG8_STAGE(PG8_SA(1, 1), a1 + hstep, voffA);
            PG8_WAIT_L(8); PG8_BAR; PG8_WAIT_L(0); PG8_MMA(0, 0, At, B0); PG8_BAR; PG8_SCHED;
            PG8_LDB(B1, 0, 1); PG8_STAGE(PG8_SB(0, 0), b2, voffB);
            PG8_BAR; PG8_WAIT_L(0); PG8_MMA(0, 1, At, B1); PG8_BAR;
            PG8_LDA(At, 0, 1); PG8_STAGE(PG8_SA(0, 0), a2, voffA);
            PG8_BAR; PG8_WAIT_L(0); PG8_MMA(1, 0, At, B0); PG8_BAR; PG8_SCHED;
            PG8_STAGE(PG8_SB(0, 1), b2 + hstep, voffB);
            PG8_WAIT_V(6); PG8_BAR; PG8_MMA(1, 1, At, B1); PG8_BAR;
            PG8_LDB(B0, 1, 0); PG8_SCHED; PG8_LDA(At, 1, 0); PG8_STAGE(PG8_SA(0, 1), a2 + hstep, voffA);
            PG8_WAIT_L(8); PG8_BAR; PG8_WAIT_L(0); PG8_MMA(0, 0, At, B0); PG8_BAR; PG8_SCHED;
            PG8_LDB(B1, 1, 1); PG8_STAGE(PG8_SB(1, 0), b3, voffB);
            PG8_BAR; PG8_WAIT_L(0); PG8_MMA(0, 1, At, B1); PG8_BAR;
            PG8_LDA(At, 1, 1); PG8_STAGE(PG8_SA(1, 0), a3, voffA);
            PG8_BAR; PG8_WAIT_L(0); PG8_MMA(1, 0, At, B0); PG8_BAR; PG8_SCHED;
            PG8_STAGE(PG8_SB(1, 1), b3 + hstep, voffB);
            PG8_WAIT_V(6); PG8_BAR; PG8_MMA(1, 1, At, B1); PG8_BAR;
            }
        }
        if constexpr (ALIGN_EPI) { if (wr == 0) PG8_BAR; }
        if constexpr (!Epi::AFTER_DRAIN) { E(acc, cur, wr, wc, fr, fq); S.done(cur); }
        if (!has_next) break;
#pragma unroll
        for (int a = 0; a < 2; ++a)
#pragma unroll
            for (int b = 0; b < 2; ++b)
#pragma unroll
                for (int m = 0; m < 4; ++m)
#pragma unroll
                    for (int n = 0; n < 2; ++n) acc[a][b][m][n] = (f32x4){0.f, 0.f, 0.f, 0.f};
        cur = nxt; cA = nA; cB = nB; ++ui;
        if constexpr (ALIGN_EPI) { if (wr == 1) PG8_BAR; }
    }
    PG8_WAIT_V(0);
    if constexpr (!ALIGN_EPI) { if (wr == 0) PG8_BAR; }
    PG8_BAR;
    if constexpr (Epi::AFTER_DRAIN) { E.fused(acc, cur, wr, wc, fr, fq, lds, wid, lane); S.done(cur); }
#undef PG8_SA
#undef PG8_SB
#undef PG8_STAGE
#undef PG8_LDA
#undef PG8_LDB
#undef PG8_MMA
#undef PG8_WAIT_V
#undef PG8_WAIT_L
#undef PG8_BAR
#undef PG8_SCHED
}
}

#ifndef PROBE
#define PROBE 0
#endif
#ifndef ONE_LAUNCH
#define ONE_LAUNCH 1
#endif
constexpr int DM = 2048, SEQ = 4096, NB = 4, CTXL = 256, NLAT = NB * SEQ, NCTX = NB * CTXL, NROW = NLAT + NCTX;
constexpr int EPROJ = 6144, DFF = 5504, DFF2 = 11008, MOD6 = 12288, DOWNP = 1280, QW = 3072, KVW = 4096;
constexpr int KSPLIT = 32;
constexpr float EPS = 1e-6f;
constexpr size_t MiB = 1u << 20;
constexpr size_t WS_MOD = 1 * MiB;
constexpr size_t WS_TAB128 = 1 * MiB + 512 * 1024, WS_TAB64 = WS_TAB128 + 64 * 32 * 8;
constexpr size_t WS_GAINS = 1 * MiB + 768 * 1024;
constexpr size_t WS_SSKV = 2 * MiB;
constexpr size_t WS_SSQ = 3 * MiB;
constexpr size_t WS_MODP = 2 * MiB;
constexpr size_t WS_XC = 18 * MiB;
constexpr size_t WS_WEIN = 26 * MiB;
constexpr size_t WS_WEOUT = 50 * MiB;
constexpr size_t WS_WFIN = 58 * MiB;
constexpr size_t WFIN_STRIDE = (size_t)DFF2 * DM * 2;
constexpr size_t WS_WFOUT = 144 * MiB;
constexpr size_t WFOUT_STRIDE = (size_t)DM * DFF * 2;
constexpr size_t WS_WDOWN = 187 * MiB;
constexpr size_t WS_WUQ = 192 * MiB;
constexpr size_t WS_WUKV = 195 * MiB;
constexpr size_t WS_WMOUT = 199 * MiB;
constexpr size_t WS_H = 208 * MiB + 4096;
constexpr size_t WS_R = 280 * MiB;
constexpr size_t WS_QKV = WS_R;
constexpr size_t WS_O = WS_R + 204 * MiB;
constexpr size_t WS_SLAB = WS_R + 340 * MiB;
constexpr size_t WS_DIFFP = WS_R + 272 * MiB;
constexpr int UCH_T0 = 22, UCH_T1 = 21, ULD = UCH_T0 * 256;
constexpr size_t WS_U = WS_R;
constexpr size_t WS_ACT = WS_R;
constexpr size_t WS_PART = WS_R + 272 * MiB;
constexpr size_t WS_DOWN = WS_R;
constexpr size_t WS_QLAT = WS_R + 86 * MiB;
constexpr size_t WS_KVLAT = WS_R + 102 * MiB;
constexpr size_t WS_KROPE = WS_R + 120 * MiB;
constexpr size_t WS_Q1 = WS_R + 124 * MiB;
constexpr size_t WS_KV1 = WS_R + 220 * MiB;
constexpr size_t WS_O1 = WS_R + 356 * MiB;
constexpr size_t WS_XB = WS_R + 420 * MiB;
constexpr size_t WS_END = WS_R + 484 * MiB;

typedef unsigned short bf16_t;
typedef float f32x4 __attribute__((ext_vector_type(4)));
typedef short bf16x8 __attribute__((ext_vector_type(8)));
typedef short s16x4 __attribute__((ext_vector_type(4)));
typedef float f32x16 __attribute__((ext_vector_type(16)));
typedef unsigned u32x4 __attribute__((ext_vector_type(4)));
typedef unsigned u32x2 __attribute__((ext_vector_type(2)));
#define LAS __attribute__((address_space(3)))


__device__ __forceinline__ int otid() { int t = threadIdx.x; asm volatile("" : "+v"(t)); return t; }
__device__ __forceinline__ int obid() { int b = blockIdx.x; asm volatile("" : "+s"(b)); return b; }
struct KP { const float* in[30]; float* out; unsigned char* ws; int ph_lo, ph_hi; };
typedef const __attribute__((address_space(4))) KP* KPP;

__device__ __forceinline__ unsigned f2bf(float f) { unsigned u = __builtin_bit_cast(unsigned, f); return (u + 0x7fffu + ((u >> 16) & 1u)) >> 16; }
__device__ __forceinline__ unsigned pk2(float lo, float hi) { return f2bf(lo) | (f2bf(hi) << 16); }
__device__ __forceinline__ float bflo(unsigned w) { return __builtin_bit_cast(float, w << 16); }
__device__ __forceinline__ float bfhi(unsigned w) { return __builtin_bit_cast(float, w & 0xffff0000u); }
__device__ __forceinline__ void unpack8(u32x4 w, float* x) { x[0] = bflo(w.x); x[1] = bfhi(w.x); x[2] = bflo(w.y); x[3] = bfhi(w.y); x[4] = bflo(w.z); x[5] = bfhi(w.z); x[6] = bflo(w.w); x[7] = bfhi(w.w); }
__device__ __forceinline__ u32x4 pack8(const float* x) { u32x4 w; w.x = pk2(x[0], x[1]); w.y = pk2(x[2], x[3]); w.z = pk2(x[4], x[5]); w.w = pk2(x[6], x[7]); return w; }
__device__ __forceinline__ float wave_sum(float v) {
#pragma unroll
    for (int o = 1; o < 64; o <<= 1) v += __shfl_xor(v, o);
    return v;
}
template <int W> __device__ __forceinline__ float grp_sum(float v) {
#pragma unroll
    for (int o = 1; o < W; o <<= 1) v += __shfl_xor(v, o);
    return v;
}
__device__ __forceinline__ float silu_f(float x) { return x / (1.f + __expf(-x)); }

struct EpiF32 { static constexpr bool PERM = true, AFTER_DRAIN = false; float* O; int ldc;
    __device__ __forceinline__ void operator()(const pg8::f32x4 (&acc)[2][2][4][2], const pg8::Unit& u, int wr, int wc, int fr, int fq) const {
        const int row0 = u.pm * 256 + wr * 64 + fr, col0 = u.pn * 256 + wc * 32 + 8 * fq;
#pragma unroll
        for (int ai = 0; ai < 2; ++ai)
#pragma unroll
            for (int m = 0; m < 4; ++m) { float* rowp = O + (size_t)(row0 + ai * 128 + m * 16) * ldc + col0;
#pragma unroll
                for (int bj = 0; bj < 2; ++bj) { *(pg8::f32x4*)(rowp + bj * 128) = acc[ai][bj][m][0]; *(pg8::f32x4*)(rowp + bj * 128 + 4) = acc[ai][bj][m][1]; } }
    }
};
struct EpiRes { static constexpr bool PERM = true, AFTER_DRAIN = false;
    const void* src; void* dst; const float* mod; int gate_off; float* part; bool src16, dst16;
    __device__ __forceinline__ void operator()(const pg8::f32x4 (&acc)[2][2][4][2], const pg8::Unit& u, int wr, int wc, int fr, int fq) const {
        if (u.ks >= 0) {
            float* pb = part + ((size_t)u.ks * NCTX + (size_t)(u.pm - 64) * 256 + wr * 64 + fr) * DM + u.pn * 256 + wc * 32 + 8 * fq;
#pragma unroll
            for (int ai = 0; ai < 2; ++ai)
#pragma unroll
                for (int m = 0; m < 4; ++m)
#pragma unroll
                    for (int bj = 0; bj < 2; ++bj) { float* q = pb + (size_t)(ai * 128 + m * 16) * DM + bj * 128; *(pg8::f32x4*)q = acc[ai][bj][m][0]; *(pg8::f32x4*)(q + 4) = acc[ai][bj][m][1]; }
            return;
        }
        const float* g = mod + (size_t)(u.pm >> 4) * MOD6 + gate_off;
        const int lrow0 = u.pm * 256 + wr * 64 + fr, col0 = u.pn * 256 + wc * 32 + 8 * fq;
        pg8::f32x4 gv[2][2];
#pragma unroll
        for (int bj = 0; bj < 2; ++bj)
#pragma unroll
            for (int n = 0; n < 2; ++n) gv[bj][n] = *(const pg8::f32x4*)(g + col0 + bj * 128 + 4 * n);
#pragma unroll
        for (int ai = 0; ai < 2; ++ai)
#pragma unroll
            for (int m = 0; m < 4; ++m) { const size_t off = (size_t)(lrow0 + ai * 128 + m * 16) * DM + col0;
#pragma unroll
                for (int bj = 0; bj < 2; ++bj) {
                    pg8::f32x4 s0, s1;
                    if (src16) { const pg8::u32x4 w = *(const pg8::u32x4*)((const bf16_t*)src + off + bj * 128);
                        s0 = (pg8::f32x4){bflo(w.x), bfhi(w.x), bflo(w.y), bfhi(w.y)}; s1 = (pg8::f32x4){bflo(w.z), bfhi(w.z), bflo(w.w), bfhi(w.w)}; }
                    else { s0 = *(const pg8::f32x4*)((const float*)src + off + bj * 128); s1 = *(const pg8::f32x4*)((const float*)src + off + bj * 128 + 4); }
                    const pg8::f32x4 x0 = s0 + gv[bj][0] * acc[ai][bj][m][0], x1 = s1 + gv[bj][1] * acc[ai][bj][m][1];
                    if (dst16) { pg8::u32x4 w; w.x = pg8::cvt_pk_bf16(x0[0], x0[1]); w.y = pg8::cvt_pk_bf16(x0[2], x0[3]); w.z = pg8::cvt_pk_bf16(x1[0], x1[1]); w.w = pg8::cvt_pk_bf16(x1[2], x1[3]);
                        *(pg8::u32x4*)((bf16_t*)dst + off + bj * 128) = w; }
                    else { *(pg8::f32x4*)((float*)dst + off + bj * 128) = x0; *(pg8::f32x4*)((float*)dst + off + bj * 128 + 4) = x1; } } }
    }
};


__device__ __forceinline__ float dpp_ror1(float v) { return __builtin_bit_cast(float, __builtin_amdgcn_update_dpp(0, __builtin_bit_cast(int, v), 0x121, 0xf, 0xf, false)); }
__device__ __forceinline__ float dpp_ror15(float v) { return __builtin_bit_cast(float, __builtin_amdgcn_update_dpp(0, __builtin_bit_cast(int, v), 0x12F, 0xf, 0xf, false)); }
__device__ __forceinline__ pg8::f32x4 ror1_4(pg8::f32x4 v) { return (pg8::f32x4){dpp_ror1(v[0]), dpp_ror1(v[1]), dpp_ror1(v[2]), dpp_ror1(v[3])}; }
__device__ __forceinline__ pg8::f32x4 ror15_4(pg8::f32x4 v) { return (pg8::f32x4){dpp_ror15(v[0]), dpp_ror15(v[1]), dpp_ror15(v[2]), dpp_ror15(v[3])}; }
struct EpiConv { static constexpr bool PERM = true, AFTER_DRAIN = false;
    bf16_t* ACT; const float* cw; int nrows; LAS float* X;
    __device__ __forceinline__ void operator()(const pg8::f32x4 (&acc)[2][2][4][2], const pg8::Unit& u, int wr, int wc, int fr, int fq) const {
        typedef pg8::f32x4 v4;
        const int lc = wc * 32 + 8 * fq, ch0 = u.pn * 128 + lc;
#pragma unroll
        for (int ai = 0; ai < 2; ++ai) { const int gi = ai * 2 + wr;
#pragma unroll
            for (int bj = 0; bj < 2; ++bj)
#pragma unroll
                for (int n = 0; n < 2; ++n) {
                    if (fr == 0) *(LAS v4*)(X + (gi * 2 + 0) * 256 + bj * 128 + lc + 4 * n) = acc[ai][bj][0][n];
                    if (fr == 15) *(LAS v4*)(X + (gi * 2 + 1) * 256 + bj * 128 + lc + 4 * n) = acc[ai][bj][3][n];
                } }
        asm volatile("s_waitcnt lgkmcnt(0)" ::: "memory"); __builtin_amdgcn_s_barrier(); asm volatile("" ::: "memory");
        const v4 z4 = (v4){0.f, 0.f, 0.f, 0.f};
        unsigned pk[2][4][2], pk0[2][4][2];
#pragma unroll
        for (int n = 0; n < 2; ++n) {
            const v4 wa0 = *(const v4*)(cw + ch0 + 4 * n), wa1 = *(const v4*)(cw + DFF2 + ch0 + 4 * n), wa2 = *(const v4*)(cw + 2 * DFF2 + ch0 + 4 * n);
            const v4 wb0 = *(const v4*)(cw + DFF + ch0 + 4 * n), wb1 = *(const v4*)(cw + DFF2 + DFF + ch0 + 4 * n), wb2 = *(const v4*)(cw + 2 * DFF2 + DFF + ch0 + 4 * n);
#pragma unroll
            for (int ai = 0; ai < 2; ++ai) { const int gi = ai * 2 + wr;
                const v4 hpa = gi > 0 ? *(const LAS v4*)(X + ((gi - 1) * 2 + 1) * 256 + lc + 4 * n) : z4, hpb = gi > 0 ? *(const LAS v4*)(X + ((gi - 1) * 2 + 1) * 256 + 128 + lc + 4 * n) : z4;
                const v4 hna = gi < 3 ? *(const LAS v4*)(X + ((gi + 1) * 2 + 0) * 256 + lc + 4 * n) : z4, hnb = gi < 3 ? *(const LAS v4*)(X + ((gi + 1) * 2 + 0) * 256 + 128 + lc + 4 * n) : z4;
#pragma unroll
                for (int m = 0; m < 4; ++m) {
                    const int r = ai * 128 + wr * 64 + m * 16 + fr, R = 254 * u.pm - 1 + r;
                    const bool isctx = R >= NLAT; const int t = isctx ? ((R - NLAT) & (CTXL - 1)) : (R & (SEQ - 1));
                    const float mp = t != 0 ? 1.f : 0.f, mn = t != (isctx ? CTXL - 1 : SEQ - 1) ? 1.f : 0.f;
                    const v4 va = acc[ai][0][m][n], vb = acc[ai][1][m][n];
                    const v4 ra = ror1_4(va), rb = ror1_4(vb), la = ror15_4(va), lb = ror15_4(vb);
                    v4 pa, pb, na, nb;
                    if (m == 0) { pa = hpa; pb = hpb; } else { pa = ror1_4(acc[ai][0][m - 1][n]); pb = ror1_4(acc[ai][1][m - 1][n]); }
                    if (m == 3) { na = hna; nb = hnb; } else { na = ror15_4(acc[ai][0][m + 1][n]); nb = ror15_4(acc[ai][1][m + 1][n]); }
                    const v4 prev_a = fr == 0 ? pa : ra, prev_b = fr == 0 ? pb : rb, next_a = fr == 15 ? na : la, next_b = fr == 15 ? nb : lb;
                    const v4 ca = wa1 * va + (wa0 * prev_a) * mp + (wa2 * next_a) * mn;
                    const v4 cb = wb1 * vb + (wb0 * prev_b) * mp + (wb2 * next_b) * mn;
                    float y[4];
#pragma unroll
                    for (int i = 0; i < 4; ++i) y[i] = ca[i] * __builtin_amdgcn_rcpf(1.f + __builtin_amdgcn_exp2f(-1.4426950408889634f * ca[i])) * cb[i];
                    pk[ai][m][0] = pg8::cvt_pk_bf16(y[0], y[1]); pk[ai][m][1] = pg8::cvt_pk_bf16(y[2], y[3]);
                    if (n == 1) {
                    }
                    if (n == 0) { pk0[ai][m][0] = pk[ai][m][0]; pk0[ai][m][1] = pk[ai][m][1]; }
                    else if (r >= 1 && r <= 254 && R < nrows) {
                        pg8::u32x4 w; w.x = pk0[ai][m][0]; w.y = pk0[ai][m][1]; w.z = pk[ai][m][0]; w.w = pk[ai][m][1];
                        __builtin_nontemporal_store(w, (pg8::u32x4*)(ACT + (size_t)R * DFF + ch0)); }
                } }
        }
    }
};

struct SplitOrder {
    int nN, nlat, nsplit, G, c, npairs;
    __device__ __forceinline__ void init(int N, int K, int G_, int c_, bool has_ctx) { nN = N / 256; nlat = 64 * nN; nsplit = has_ctx ? 256 : 0; G = G_; c = c_; npairs = K / 128; }
    __device__ __forceinline__ bool next(int i, pg8::Unit& u) const {
        const int L = i * G + c;
        if (L >= nlat + nsplit) return false;
        int pm, pn, k0 = 0, nt = 0, ks = -1;
        if (L < nlat) {
            const int q = nlat / 8, xcd = L % 8, off = L / 8; const int wgid = xcd * q + off;
            const int nig = 4 * nN; const int gid = wgid / nig, fm = gid * 4;
            pm = fm + ((wgid % nig) % 4); pn = (wgid % nig) / 4;
        } else {
            const int s = L - nlat, base = npairs >> 3, rem = npairs & 7;
            ks = (s >> 3) & 7; pn = s & 7; pm = 64 + (s >> 6); k0 = 2 * (ks * base + min(ks, rem)); nt = 2 * (base + (ks < rem ? 1 : 0));
        }
        u.pm = pm; u.pn = pn; u.k0 = k0; u.nt = nt; u.ks = ks; return true;
    }
    __device__ __forceinline__ void a_ready(const pg8::Unit&) const {}
    __device__ __forceinline__ void done(const pg8::Unit&) const {}
};


struct EpiQK { static constexpr bool PERM = true, AFTER_DRAIN = false;
    bf16_t* O; const float* gains; LAS float* X; bf16_t* SL;
    __device__ __forceinline__ void operator()(const pg8::f32x4 (&acc)[2][2][4][2], const pg8::Unit& u, int wr, int wc, int fr, int fq) const {
        typedef pg8::f32x4 v4;
        asm volatile("" : "+v"(fr), "+v"(fq));
        const int sec = u.pn >> 2;
        const int row0 = u.pm * 256 + wr * 64 + fr, colt = u.pn * 256;
        if (sec == 2 || sec == 5) {
            const int col0 = colt + wc * 32 + 8 * fq;
#pragma unroll
            for (int ai = 0; ai < 2; ++ai)
#pragma unroll
                for (int m = 0; m < 4; ++m) { bf16_t* rowp = SL + ((size_t)((sec == 2 ? 8 : 24) + (u.pn & 3) * 2) * NROW + (row0 + ai * 128 + m * 16)) * 128 + wc * 32 + 8 * fq;
#pragma unroll
                    for (int bj = 0; bj < 2; ++bj) { const v4 v0 = acc[ai][bj][m][0], v1 = acc[ai][bj][m][1];
                        pg8::u32x4 w; w.x = pg8::cvt_pk_bf16(v0[0], v0[1]); w.y = pg8::cvt_pk_bf16(v0[2], v0[3]); w.z = pg8::cvt_pk_bf16(v1[0], v1[1]); w.w = pg8::cvt_pk_bf16(v1[2], v1[3]);
                        *(pg8::u32x4*)(rowp + (size_t)bj * NROW * 128) = w; } }
            return;
        }
#pragma unroll
        for (int ai = 0; ai < 2; ++ai)
#pragma unroll
            for (int m = 0; m < 4; ++m)
#pragma unroll
                for (int bj = 0; bj < 2; ++bj) { const v4 a = acc[ai][bj][m][0], b = acc[ai][bj][m][1];
                    float sq = ((a[0] * a[0] + a[1] * a[1]) + (a[2] * a[2] + a[3] * a[3])) + ((b[0] * b[0] + b[1] * b[1]) + (b[2] * b[2] + b[3] * b[3]));
                    sq += __shfl_xor(sq, 16); sq += __shfl_xor(sq, 32);
                    if (fq == 0) X[((ai * 128 + wr * 64 + m * 16 + fr) * 2 + bj) * 4 + wc] = sq; }
        asm volatile("s_waitcnt lgkmcnt(0)" ::: "memory"); __builtin_amdgcn_s_barrier(); asm volatile("" ::: "memory");
        const bool perm = sec >= 3, rope = perm && u.pm < 64;
        const float* gain = gains + (sec < 2 ? sec : sec - 1) * 128;
        const int ld0 = perm ? 64 * (wc >> 1) + 16 * (wc & 1) + 4 * fq : 32 * wc + 8 * fq, ld1 = perm ? ld0 + 32 : ld0 + 4;
        const v4 g0 = *(const v4*)(gain + ld0), g1 = *(const v4*)(gain + ld1);
        float frev[4];
#pragma unroll
        for (int i = 0; i < 4; ++i) frev[i] = __builtin_amdgcn_exp2f(-13.287712379549449f * (float)((ld0 & 31) + i) * (1.f / 32.f)) * 0.15915494309189535f;
#pragma unroll
        for (int ai = 0; ai < 2; ++ai)
#pragma unroll
            for (int m = 0; m < 4; ++m) { const int row = row0 + ai * 128 + m * 16, t = row & (SEQ - 1); const float pos = (float)((wc >> 1) ? (t & 63) : (t >> 6));
                float cs[4], sn[4];
#pragma unroll
                for (int i = 0; i < 4; ++i) { const float rv = __builtin_amdgcn_fractf(pos * frev[i]); cs[i] = rope ? __builtin_amdgcn_cosf(rv) : 1.f; sn[i] = rope ? __builtin_amdgcn_sinf(rv) : 0.f; }
                const bool isk = sec == 1 || sec == 4;
                bf16_t* rowp = isk ? SL + ((size_t)((sec == 1 ? 0 : 16) + (u.pn & 3) * 2) * NROW + row) * 128 : O + (size_t)row * EPROJ + colt;
                const size_t hstride = isk ? (size_t)NROW * 128 : 128;
#pragma unroll
                for (int bj = 0; bj < 2; ++bj) { const v4 P4 = *(const LAS v4*)(X + ((ai * 128 + wr * 64 + m * 16 + fr) * 2 + bj) * 4);
                    const float rstd = rsqrtf(((P4[0] + P4[1]) + (P4[2] + P4[3])) * (1.f / 128.f) + EPS);
                    const v4 y0 = acc[ai][bj][m][0] * rstd * g0, y1 = acc[ai][bj][m][1] * rstd * g1;
                    float o0[4], o1[4];
#pragma unroll
                    for (int i = 0; i < 4; ++i) { o0[i] = y0[i] * cs[i] - y1[i] * sn[i]; o1[i] = y1[i] * cs[i] + y0[i] * sn[i]; }
                    u32x2 w0, w1; w0.x = pg8::cvt_pk_bf16(o0[0], o0[1]); w0.y = pg8::cvt_pk_bf16(o0[2], o0[3]); w1.x = pg8::cvt_pk_bf16(o1[0], o1[1]); w1.y = pg8::cvt_pk_bf16(o1[2], o1[3]);
                    *(u32x2*)(rowp + bj * hstride + ld0) = w0; *(u32x2*)(rowp + bj * hstride + ld1) = w1; } }
    }
};


struct EpiDown { static constexpr bool PERM = true, AFTER_DRAIN = false;
    bf16_t* QL; bf16_t* KVL; bf16_t* KR; float* SSKV; float* SSQ; const float* g_q; const float* g_kv; const float* g_kr; LAS float* X;
    __device__ __forceinline__ void operator()(const pg8::f32x4 (&acc)[2][2][4][2], const pg8::Unit& u, int wr, int wc, int fr, int fq) const {
        typedef pg8::f32x4 v4;
        asm volatile("" : "+v"(fr), "+v"(fq));
        const int row0 = u.pm * 256 + wr * 64 + fr, lc = wc * 32 + 8 * fq;
        if (u.pn < 4) {
            const bool isq = u.pn < 2; if (isq && u.pm >= 64) return;
            const int cb = (u.pn & 1) * 256 + lc; const float* gp = (isq ? g_q : g_kv) + cb; bf16_t* ob = (isq ? QL : KVL) + cb;
            v4 g[2][2];
#pragma unroll
            for (int bj = 0; bj < 2; ++bj) { g[bj][0] = *(const v4*)(gp + bj * 128); g[bj][1] = *(const v4*)(gp + bj * 128 + 4); }
#pragma unroll
            for (int ai = 0; ai < 2; ++ai)
#pragma unroll
                for (int m = 0; m < 4; ++m) { const int row = row0 + ai * 128 + m * 16; float sq = 0.f;
#pragma unroll
                    for (int bj = 0; bj < 2; ++bj) { const v4 a = acc[ai][bj][m][0], b = acc[ai][bj][m][1];
                        sq += ((a[0] * a[0] + a[1] * a[1]) + (a[2] * a[2] + a[3] * a[3])) + ((b[0] * b[0] + b[1] * b[1]) + (b[2] * b[2] + b[3] * b[3]));
                        const v4 y0 = a * g[bj][0], y1 = b * g[bj][1];
                        pg8::u32x4 w; w.x = pg8::cvt_pk_bf16(y0[0], y0[1]); w.y = pg8::cvt_pk_bf16(y0[2], y0[3]); w.z = pg8::cvt_pk_bf16(y1[0], y1[1]); w.w = pg8::cvt_pk_bf16(y1[2], y1[3]);
                        *(pg8::u32x4*)(ob + (size_t)row * 512 + bj * 128) = w; }
                    sq += __shfl_xor(sq, 16); sq += __shfl_xor(sq, 32); if (fq == 0) (isq ? SSQ : SSKV)[(size_t)row * 8 + (u.pn & 1) * 4 + wc] = sq; }
            return;
        }
#pragma unroll
        for (int ai = 0; ai < 2; ++ai)
#pragma unroll
            for (int m = 0; m < 4; ++m) { const v4 a = acc[ai][0][m][0], b = acc[ai][0][m][1];
                float sq = ((a[0] * a[0] + a[1] * a[1]) + (a[2] * a[2] + a[3] * a[3])) + ((b[0] * b[0] + b[1] * b[1]) + (b[2] * b[2] + b[3] * b[3]));
                sq += __shfl_xor(sq, 16); sq += __shfl_xor(sq, 32);
                if (fq == 0) X[(ai * 128 + wr * 64 + m * 16 + fr) * 4 + wc] = sq; }
        asm volatile("s_waitcnt lgkmcnt(0)" ::: "memory"); __builtin_amdgcn_s_barrier(); asm volatile("" ::: "memory");
        if (wc >= 2) return;
        const bool rope = u.pm < 64;
        const int ld0 = 32 * wc + 4 * fq, ld1 = ld0 + 16;
        const v4 g0 = *(const v4*)(g_kr + ld0), g1 = *(const v4*)(g_kr + ld1);
        float frev[4];
#pragma unroll
        for (int i = 0; i < 4; ++i) frev[i] = __builtin_amdgcn_exp2f(-13.287712379549449f * (float)(4 * fq + i) * (1.f / 16.f)) * 0.15915494309189535f;
#pragma unroll
        for (int ai = 0; ai < 2; ++ai)
#pragma unroll
            for (int m = 0; m < 4; ++m) { const int row = row0 + ai * 128 + m * 16, t = row & (SEQ - 1); const float pos = (float)(wc ? (t & 63) : (t >> 6));
                const v4 P4 = *(const LAS v4*)(X + (ai * 128 + wr * 64 + m * 16 + fr) * 4);
                const float rstd = rsqrtf((P4[0] + P4[1]) * (1.f / 64.f) + EPS);
                const v4 y0 = acc[ai][0][m][0] * rstd * g0, y1 = acc[ai][0][m][1] * rstd * g1;
                float o0[4], o1[4];
#pragma unroll
                for (int i = 0; i < 4; ++i) { const float rv = __builtin_amdgcn_fractf(pos * frev[i]); const float c = rope ? __builtin_amdgcn_cosf(rv) : 1.f, sn = rope ? __builtin_amdgcn_sinf(rv) : 0.f;
                    o0[i] = y0[i] * c - y1[i] * sn; o1[i] = y1[i] * c + y0[i] * sn; }
                u32x2 w0, w1; w0.x = pg8::cvt_pk_bf16(o0[0], o0[1]); w0.y = pg8::cvt_pk_bf16(o0[2], o0[3]); w1.x = pg8::cvt_pk_bf16(o1[0], o1[1]); w1.y = pg8::cvt_pk_bf16(o1[2], o1[3]);
                *(u32x2*)(KR + (size_t)row * 64 + ld0) = w0; *(u32x2*)(KR + (size_t)row * 64 + ld1) = w1; }
    }
};

struct EpiKV { static constexpr bool PERM = true, AFTER_DRAIN = false;
    bf16_t* O; const float* gain; LAS float* X; const float* SSKV;
    __device__ __forceinline__ void operator()(const pg8::f32x4 (&acc)[2][2][4][2], const pg8::Unit& u, int wr, int wc, int fr, int fq) const {
        typedef pg8::f32x4 v4;
        asm volatile("" : "+v"(fr), "+v"(fq));
        const int row0 = u.pm * 256 + wr * 64 + fr, col0 = u.pn * 256 + wc * 32 + 8 * fq;
        v4 sk[2][4][2];
#pragma unroll
        for (int ai = 0; ai < 2; ++ai)
#pragma unroll
            for (int m = 0; m < 4; ++m) { const float* q = SSKV + (size_t)(row0 + ai * 128 + m * 16) * 8; sk[ai][m][0] = *(const v4*)q; sk[ai][m][1] = *(const v4*)(q + 4); }
        float rkv[2][4];
#pragma unroll
        for (int ai = 0; ai < 2; ++ai)
#pragma unroll
            for (int m = 0; m < 4; ++m) { const v4 sa = sk[ai][m][0], sb = sk[ai][m][1];
                rkv[ai][m] = rsqrtf((((sa[0] + sa[1]) + (sa[2] + sa[3])) + ((sb[0] + sb[1]) + (sb[2] + sb[3]))) * (1.f / 512.f) + EPS);
                const v4 a = acc[ai][0][m][0] * rkv[ai][m], b = acc[ai][0][m][1] * rkv[ai][m];
                float sq = ((a[0] * a[0] + a[1] * a[1]) + (a[2] * a[2] + a[3] * a[3])) + ((b[0] * b[0] + b[1] * b[1]) + (b[2] * b[2] + b[3] * b[3]));
                sq += __shfl_xor(sq, 16); sq += __shfl_xor(sq, 32);
                if (fq == 0) X[(ai * 128 + wr * 64 + m * 16 + fr) * 4 + wc] = sq; }
        asm volatile("s_waitcnt lgkmcnt(0)" ::: "memory"); __builtin_amdgcn_s_barrier(); asm volatile("" ::: "memory");
        const v4 g0 = *(const v4*)(gain + wc * 32 + 8 * fq), g1 = *(const v4*)(gain + wc * 32 + 8 * fq + 4);
#pragma unroll
        for (int ai = 0; ai < 2; ++ai)
#pragma unroll
            for (int m = 0; m < 4; ++m) { const v4 P4 = *(const LAS v4*)(X + (ai * 128 + wr * 64 + m * 16 + fr) * 4);
                const float rstd = rsqrtf(((P4[0] + P4[1]) + (P4[2] + P4[3])) * (1.f / 128.f) + EPS) * rkv[ai][m];
                bf16_t* rowp = O + (size_t)(row0 + ai * 128 + m * 16) * KVW + col0;
                const v4 k0 = acc[ai][0][m][0] * rstd * g0, k1 = acc[ai][0][m][1] * rstd * g1, v0 = acc[ai][1][m][0] * rkv[ai][m], v1 = acc[ai][1][m][1] * rkv[ai][m];
                pg8::u32x4 w; w.x = pg8::cvt_pk_bf16(k0[0], k0[1]); w.y = pg8::cvt_pk_bf16(k0[2], k0[3]); w.z = pg8::cvt_pk_bf16(k1[0], k1[1]); w.w = pg8::cvt_pk_bf16(k1[2], k1[3]);
                *(pg8::u32x4*)rowp = w;
                w.x = pg8::cvt_pk_bf16(v0[0], v0[1]); w.y = pg8::cvt_pk_bf16(v0[2], v0[3]); w.z = pg8::cvt_pk_bf16(v1[0], v1[1]); w.w = pg8::cvt_pk_bf16(v1[2], v1[3]);
                *(pg8::u32x4*)(rowp + 128) = w; }
    }
};
struct EpiQ1 { static constexpr bool PERM = true, AFTER_DRAIN = false;
    bf16_t* O; const float* g_nope; const float* g_rope; LAS float* X; const float* SSQ;
    __device__ __forceinline__ void operator()(const pg8::f32x4 (&acc)[2][2][4][2], const pg8::Unit& u, int wr, int wc, int fr, int fq) const {
        typedef pg8::f32x4 v4;
        asm volatile("" : "+v"(fr), "+v"(fq));
        const bool rp = u.pn >= 8;
        const int row0 = u.pm * 256 + wr * 64 + fr, colt = u.pn * 256;
        v4 sk[2][4][2];
#pragma unroll
        for (int ai = 0; ai < 2; ++ai)
#pragma unroll
            for (int m = 0; m < 4; ++m) { const float* q = SSQ + (size_t)(row0 + ai * 128 + m * 16) * 8; sk[ai][m][0] = *(const v4*)q; sk[ai][m][1] = *(const v4*)(q + 4); }
        float rq[2][4];
#pragma unroll
        for (int ai = 0; ai < 2; ++ai)
#pragma unroll
            for (int m = 0; m < 4; ++m) { const v4 sa = sk[ai][m][0], sb = sk[ai][m][1]; rq[ai][m] = rsqrtf((((sa[0] + sa[1]) + (sa[2] + sa[3])) + ((sb[0] + sb[1]) + (sb[2] + sb[3]))) * (1.f / 512.f) + EPS); }
#pragma unroll
        for (int ai = 0; ai < 2; ++ai)
#pragma unroll
            for (int m = 0; m < 4; ++m)
#pragma unroll
                for (int bj = 0; bj < 2; ++bj) { const v4 a = acc[ai][bj][m][0] * rq[ai][m], b = acc[ai][bj][m][1] * rq[ai][m];
                    float sq = ((a[0] * a[0] + a[1] * a[1]) + (a[2] * a[2] + a[3] * a[3])) + ((b[0] * b[0] + b[1] * b[1]) + (b[2] * b[2] + b[3] * b[3]));
                    sq += __shfl_xor(sq, 16); sq += __shfl_xor(sq, 32);
                    if (fq == 0) X[((ai * 128 + wr * 64 + m * 16 + fr) * 2 + bj) * 4 + wc] = sq; }
        asm volatile("s_waitcnt lgkmcnt(0)" ::: "memory"); __builtin_amdgcn_s_barrier(); asm volatile("" ::: "memory");
        const int ld0 = rp ? 32 * (wc & 1) + 4 * fq : 32 * wc + 8 * fq, ld1 = rp ? ld0 + 16 : ld0 + 4;
        const float* gain = rp ? g_rope : g_nope;
        const v4 g0 = *(const v4*)(gain + ld0), g1 = *(const v4*)(gain + ld1);
        float frev[4];
#pragma unroll
        for (int i = 0; i < 4; ++i) frev[i] = __builtin_amdgcn_exp2f(-13.287712379549449f * (float)(4 * fq + i) * (1.f / 16.f)) * 0.15915494309189535f;
#pragma unroll
        for (int ai = 0; ai < 2; ++ai)
#pragma unroll
            for (int m = 0; m < 4; ++m) { const int row = row0 + ai * 128 + m * 16, t = row & (SEQ - 1); const float pos = (float)((wc & 1) ? (t & 63) : (t >> 6));
                float cs[4], sn[4];
#pragma unroll
                for (int i = 0; i < 4; ++i) { const float rv = __builtin_amdgcn_fractf(pos * frev[i]); cs[i] = rp ? __builtin_amdgcn_cosf(rv) : 1.f; sn[i] = rp ? __builtin_amdgcn_sinf(rv) : 0.f; }
                bf16_t* rowp = O + (size_t)row * QW + colt;
#pragma unroll
                for (int bj = 0; bj < 2; ++bj) { const v4 P4 = *(const LAS v4*)(X + ((ai * 128 + wr * 64 + m * 16 + fr) * 2 + bj) * 4);
                    const float ssum = rp ? ((wc >> 1) ? (P4[2] + P4[3]) : (P4[0] + P4[1])) : ((P4[0] + P4[1]) + (P4[2] + P4[3]));
                    const float rstd = rsqrtf(ssum * (rp ? (1.f / 64.f) : (1.f / 128.f)) + EPS) * rq[ai][m];
                    const v4 y0 = acc[ai][bj][m][0] * rstd * g0, y1 = acc[ai][bj][m][1] * rstd * g1;
                    float o0[4], o1[4];
#pragma unroll
                    for (int i = 0; i < 4; ++i) { o0[i] = y0[i] * cs[i] - y1[i] * sn[i]; o1[i] = y1[i] * cs[i] + y0[i] * sn[i]; }
                    u32x2 w0, w1; w0.x = pg8::cvt_pk_bf16(o0[0], o0[1]); w0.y = pg8::cvt_pk_bf16(o0[2], o0[3]); w1.x = pg8::cvt_pk_bf16(o1[0], o1[1]); w1.y = pg8::cvt_pk_bf16(o1[2], o1[3]);
                    const int hb = rp ? bj * 128 + (wc >> 1) * 64 : bj * 128;
                    *(u32x2*)(rowp + hb + ld0) = w0; *(u32x2*)(rowp + hb + ld1) = w1; } }
    }
};

namespace att {
constexpr int NW = 8, QBLK = 32, KVBLK = 64;
constexpr int SHM_V = 16384, SHM_K = 16384, SHM_KR = 8192;
constexpr int OFF_V = 0, OFF_K = 32768, OFF_KR = 65536, OFF_WS = 81920, OFF_TAB = 83968, OFF_QR = 86016, LDS_BYTES = 86016 + 32768;
constexpr float THR = 8.f;
#define KSWZ(row, colB) ((row) * 256 + ((colB) ^ (((row) & 7) << 4)))
#define KRSWZ(row, colB) ((row) * 128 + ((colB) ^ (((row) & 7) << 4)))
#define SBAR() __builtin_amdgcn_sched_barrier(0)
__device__ __forceinline__ int crow(int r, int hi) { return (r & 3) + 8 * (r >> 2) + 4 * hi; }
__device__ __forceinline__ unsigned cvtpk(float lo, float hi) { unsigned r; asm volatile("v_cvt_pk_bf16_f32 %0, %1, %2" : "=v"(r) : "v"(lo), "v"(hi)); return r; }

struct AUnit {
    const bf16_t* Q; int ldq;
    const bf16_t* K; const bf16_t* V; int ldk;
    const bf16_t* KR;
    int base0, n0, base1, NT;
    void* O; int ldo;
    int qrow0, krow0;
    int qroff;
};

template <int MODE> __device__ __forceinline__ void partialSM(f32x16& p0, f32x16& p1, float& m_reg, float& mn, float& alpha) {
    constexpr float SCALE = MODE == 2 ? 0.07216878364870322f : 0.08838834764831845f;
    constexpr float C = SCALE * 1.4426950408889634f;
    float pmax = p0[0];
#pragma unroll
    for (int r = 1; r < 16; ++r) pmax = fmaxf(pmax, p0[r]);
#pragma unroll
    for (int r = 0; r < 16; ++r) pmax = fmaxf(pmax, p1[r]);
    { auto rr = __builtin_amdgcn_permlane32_swap(__float_as_uint(pmax), __float_as_uint(pmax), false, false);
      pmax = fmaxf(__uint_as_float(rr[0]), __uint_as_float(rr[1])); }
    if (__builtin_expect(__all(pmax - m_reg <= THR / SCALE), 1)) { mn = m_reg; alpha = 1.f; }
    else { mn = fmaxf(m_reg, pmax); alpha = __builtin_amdgcn_exp2f((m_reg - mn) * C); m_reg = mn; }
    const float mnC = -mn * C;
#pragma unroll
    for (int r = 0; r < 16; ++r) p0[r] = fmaf(p0[r], C, mnC);
#pragma unroll
    for (int r = 0; r < 16; ++r) p1[r] = fmaf(p1[r], C, mnC);
#pragma unroll
    for (int r = 0; r < 16; ++r) p0[r] = __builtin_amdgcn_exp2f(p0[r]);
}
__device__ __forceinline__ void finishSM(f32x16& p0, f32x16& p1, float alpha, float& l_reg, bf16x8& pa0, bf16x8& pa1, bf16x8& pa2, bf16x8& pa3) {
#pragma unroll
    for (int r = 0; r < 16; ++r) p1[r] = __builtin_amdgcn_exp2f(p1[r]);
    float ps = 0;
#pragma unroll
    for (int r = 0; r < 16; ++r) ps += p0[r];
#pragma unroll
    for (int r = 0; r < 16; ++r) ps += p1[r];
    { auto rr = __builtin_amdgcn_permlane32_swap(__float_as_uint(ps), __float_as_uint(ps), false, false);
      ps = __uint_as_float(rr[0]) + __uint_as_float(rr[1]); }
    l_reg = l_reg * alpha + ps;
#define PK4(P, BASE, OUT) do { unsigned a0 = cvtpk(P[BASE + 0], P[BASE + 1]), a1 = cvtpk(P[BASE + 2], P[BASE + 3]);   \
    unsigned b0 = cvtpk(P[BASE + 4], P[BASE + 5]), b1 = cvtpk(P[BASE + 6], P[BASE + 7]);                              \
    auto r0 = __builtin_amdgcn_permlane32_swap(a0, b0, false, false); auto r1 = __builtin_amdgcn_permlane32_swap(a1, b1, false, false); \
    u32x4 w = {r0[0], r1[0], r0[1], r1[1]}; OUT = *reinterpret_cast<bf16x8*>(&w); } while (0)
    PK4(p0, 0, pa0); PK4(p0, 8, pa1); PK4(p1, 0, pa2); PK4(p1, 8, pa3);
#undef PK4
}
template <int MODE> __device__ __forceinline__ void qkt(f32x16& p0, f32x16& p1, const char* Ks, const char* KRs, const bf16x8* qr, const char* qrl, int r32, int hi) {
    p0 = f32x16{}; p1 = f32x16{};
#pragma unroll
    for (int d0 = 0; d0 < 8; ++d0) { const int cb = (d0 * 16 + hi * 8) * 2;
        bf16x8 b0 = *reinterpret_cast<const bf16x8*>(Ks + KSWZ(r32, cb));
        bf16x8 b1 = *reinterpret_cast<const bf16x8*>(Ks + KSWZ(32 + r32, cb));
        bf16x8 qv; if (MODE == 1 && d0 >= 4) qv = *reinterpret_cast<const bf16x8*>(qrl + (d0 - 4) * 1024); else qv = qr[d0];
        p0 = __builtin_amdgcn_mfma_f32_32x32x16_bf16(b0, qv, p0, 0, 0, 0);
        p1 = __builtin_amdgcn_mfma_f32_32x32x16_bf16(b1, qv, p1, 0, 0, 0); }
    if constexpr (MODE == 2) {
#pragma unroll
        for (int d0 = 0; d0 < 4; ++d0) { const int cb = (d0 * 16 + hi * 8) * 2;
            bf16x8 b0 = *reinterpret_cast<const bf16x8*>(KRs + KRSWZ(r32, cb));
            bf16x8 b1 = *reinterpret_cast<const bf16x8*>(KRs + KRSWZ(32 + r32, cb));
            const bf16x8 qv = *reinterpret_cast<const bf16x8*>(qrl + d0 * 1024);
            p0 = __builtin_amdgcn_mfma_f32_32x32x16_bf16(b0, qv, p0, 0, 0, 0);
            p1 = __builtin_amdgcn_mfma_f32_32x32x16_bf16(b1, qv, p1, 0, 0, 0); }
    }
}
__device__ __forceinline__ int v_st(int k, int c) { const int kk = (k & ~0xC) | ((k & 4) << 1) | ((k & 8) >> 1); return ((kk >> 3) * 4 + (c >> 5)) * 512 + ((kk & 7) * 32 + (c & 31)) * 2; }
__device__ __forceinline__ int v_rd_base(int lane) { return ((lane & 3) << 3) | (((lane >> 2) & 3) << 6) | (((lane >> 4) & 1) << 5) | (((lane >> 5) & 1) << 8); }
constexpr int v_rd_off(int d0, int ks, int half) { return d0 * 512 + ks * 4096 + half * 2048; }
template <int OFF> __device__ __forceinline__ s16x4 tr_read(int vb) {
    s16x4 r; asm volatile("ds_read_b64_tr_b16 %0, %1 offset:%2" : "=&v"(r) : "v"(vb), "i"(OFF) : "memory"); return r;
}
template <int D0> __device__ __forceinline__ void pv_one(f32x16& od, int vb, bf16x8 pa0, bf16x8 pa1, bf16x8 pa2, bf16x8 pa3) {
    const s16x4 l0 = tr_read<v_rd_off(D0, 0, 0)>(vb), h0 = tr_read<v_rd_off(D0, 0, 1)>(vb), l1 = tr_read<v_rd_off(D0, 1, 0)>(vb), h1 = tr_read<v_rd_off(D0, 1, 1)>(vb);
    const s16x4 l2 = tr_read<v_rd_off(D0, 2, 0)>(vb), h2 = tr_read<v_rd_off(D0, 2, 1)>(vb), l3 = tr_read<v_rd_off(D0, 3, 0)>(vb), h3 = tr_read<v_rd_off(D0, 3, 1)>(vb);
    asm volatile("s_waitcnt lgkmcnt(0)" ::: "memory"); SBAR();
#define PK(L, H) (bf16x8){L[0], L[1], L[2], L[3], H[0], H[1], H[2], H[3]}
    od = __builtin_amdgcn_mfma_f32_32x32x16_bf16(pa0, PK(l0, h0), od, 0, 0, 0);
    od = __builtin_amdgcn_mfma_f32_32x32x16_bf16(pa1, PK(l1, h1), od, 0, 0, 0);
    od = __builtin_amdgcn_mfma_f32_32x32x16_bf16(pa2, PK(l2, h2), od, 0, 0, 0);
    od = __builtin_amdgcn_mfma_f32_32x32x16_bf16(pa3, PK(l3, h3), od, 0, 0, 0);
#undef PK
}
__device__ __forceinline__ void pv_d0(f32x16* o, int vb, bf16x8 pa0, bf16x8 pa1, bf16x8 pa2, bf16x8 pa3) {
    pv_one<0>(o[0], vb, pa0, pa1, pa2, pa3); pv_one<1>(o[1], vb, pa0, pa1, pa2, pa3); pv_one<2>(o[2], vb, pa0, pa1, pa2, pa3); pv_one<3>(o[3], vb, pa0, pa1, pa2, pa3);
}
__device__ __forceinline__ void na_mask(f32x16& p0, f32x16& p1, int j, int n0, int qrow0, int krow0, int wid, int r32, int hi, const float* tab) {
    if (j >= n0) return;
    const int qrow = qrow0 + (wid >> 1), c = (wid & 1) * 32 + r32, kr = krow0 + j;
    const int rs = min(max(qrow - 4, 0), 56);
    const float NEG = -INFINITY;
    if (kr < rs || kr >= rs + 8) {
#pragma unroll
        for (int r = 0; r < 16; ++r) { p0[r] = NEG; p1[r] = NEG; }
        return;
    }
    const int dr = kr - qrow + 7, cs = min(max(c - 8, 0), 48);
    const float* trow = tab + dr * 31 + 15 - c + cs;
#pragma unroll
    for (int r = 0; r < 16; ++r) {
        const int i0 = crow(r, hi) - cs, i1 = i0 + 32;
        const bool v0 = (unsigned)i0 < 16u, v1 = (unsigned)i1 < 16u;
        const float b0 = trow[min(max(i0, 0), 15)], b1 = trow[min(max(i1, 0), 15)];
        p0[r] = v0 ? p0[r] + b0 : NEG; p1[r] = v1 ? p1[r] + b1 : NEG;
        if ((r & 3) == 3) SBAR();
    }
}

template <int MODE, bool OUTF32>
__device__ __forceinline__ void attn_unit(const AUnit& u, char* lds) {
    const int tid = otid(), wid = tid >> 6, lane = tid & 63, r32 = lane & 31, hi = lane >> 5;
    char* V_lds = lds + OFF_V; char* K_lds = lds + OFF_K; char* KR_lds = lds + OFF_KR;
    float* ws = (float*)(lds + OFF_WS) + wid * 64; float* li_l = ws; float* al_l = ws + 32;
    const float* tab = (const float*)(lds + OFF_TAB);
    float m_reg = -1e30f, l_reg = 0; f32x16 o[4] = {}; bf16x8 qr[8]; char* qrl = lds + OFF_QR + wid * 4096 + lane * 16;
    const bf16_t* Qw = u.Q + (size_t)(wid * QBLK + r32) * u.ldq + hi * 8;
#pragma unroll
    for (int d0 = 0; d0 < (MODE == 1 ? 4 : 8); ++d0) qr[d0] = *reinterpret_cast<const bf16x8*>(Qw + d0 * 16);
    if constexpr (MODE == 1) {
#pragma unroll
        for (int d0 = 0; d0 < 4; ++d0) { qr[4 + d0] = qr[d0]; *reinterpret_cast<bf16x8*>(qrl + d0 * 1024) = *reinterpret_cast<const bf16x8*>(Qw + 64 + d0 * 16); }
    }
    if constexpr (MODE == 2) {
#pragma unroll
        for (int d0 = 0; d0 < 4; ++d0) *reinterpret_cast<bf16x8*>(qrl + d0 * 1024) = *reinterpret_cast<const bf16x8*>(Qw + u.qroff + d0 * 16);
    }
    const int sr = tid >> 4, sc = (tid & 15) * 8, vst0 = v_st(sr, sc), vst1 = v_st(32 + sr, sc);
    const int krr = tid >> 3, krc = (tid & 7) * 8;
    const unsigned voff0 = (unsigned)(sr * u.ldk + sc) * 2u, voff1 = voff0 + 64u * (unsigned)u.ldk, voffr = (unsigned)(krr * 64 + krc) * 2u;
    const int vb0 = (int)(uintptr_t)(LAS char*)V_lds + v_rd_base(lane);
    constexpr int SD = 1;
    struct { bf16x8 vs0, vs1, ks0, ks1, kr; } sr_[SD];
#define TROW(j) ((j) < u.n0 ? u.base0 + 64 * (j) : u.base1 + 64 * ((j) - u.n0))
#define SLOAD(i, jt) do { const int _r = __builtin_amdgcn_readfirstlane(TROW(jt)); const char* _vb = (const char*)(u.V + (size_t)_r * u.ldk); const char* _kb = (const char*)(u.K + (size_t)_r * u.ldk); \
    sr_[i].vs0 = *reinterpret_cast<const bf16x8*>(_vb + voff0); sr_[i].vs1 = *reinterpret_cast<const bf16x8*>(_vb + voff1); \
    sr_[i].ks0 = *reinterpret_cast<const bf16x8*>(_kb + voff0); sr_[i].ks1 = *reinterpret_cast<const bf16x8*>(_kb + voff1); \
    if constexpr (MODE == 2) sr_[i].kr = *reinterpret_cast<const bf16x8*>((const char*)(u.KR + (size_t)_r * 64) + voffr); } while (0)
#define SWRITE(b, i) do { *(bf16x8*)(V_lds + (b) * SHM_V + vst0) = sr_[i].vs0; *(bf16x8*)(V_lds + (b) * SHM_V + vst1) = sr_[i].vs1; const int kc = sc * 2; \
    *(bf16x8*)(K_lds + (b) * SHM_K + KSWZ(sr, kc)) = sr_[i].ks0; *(bf16x8*)(K_lds + (b) * SHM_K + KSWZ(32 + sr, kc)) = sr_[i].ks1; \
    if constexpr (MODE == 2) *(bf16x8*)(KR_lds + (b) * SHM_KR + KRSWZ(krr, krc * 2)) = sr_[i].kr; } while (0)
#define SWAIT() do { if constexpr (SD == 1) asm volatile("s_waitcnt vmcnt(0)" ::: "memory"); else if constexpr (MODE == 2) asm volatile("s_waitcnt vmcnt(5)" ::: "memory"); else asm volatile("s_waitcnt vmcnt(4)" ::: "memory"); } while (0)
#define RESC(a) do { if (__any((a) < 1.f)) { if (hi == 0) al_l[r32] = (a); asm volatile("s_waitcnt lgkmcnt(0)" ::: "memory"); \
    _Pragma("unroll") for (int d = 0; d < 4; ++d) _Pragma("unroll") for (int r = 0; r < 16; ++r) o[d][r] *= al_l[crow(r, hi)]; } } while (0)
#ifdef DIS_NA
#define MASK(P0, P1, jt) do {} while (0)
#else
#define MASK(P0, P1, jt) do { if constexpr (MODE == 1) na_mask(P0, P1, (jt), u.n0, u.qrow0, u.krow0, wid, r32, hi, tab); } while (0)
#endif
    f32x16 pA0, pA1, pB0, pB1; float mnA, mnB, alA, alB; bf16x8 pa0, pa1, pa2, pa3; const int NT = u.NT;
    constexpr int SE = 0, SO = SD - 1;
    SLOAD(SE, 0); asm volatile("s_waitcnt vmcnt(0)" ::: "memory"); SWRITE(0, SE); __syncthreads();
    qkt<MODE>(pA0, pA1, K_lds, KR_lds, qr, qrl, r32, hi); MASK(pA0, pA1, 0); partialSM<MODE>(pA0, pA1, m_reg, mnA, alA);
    SLOAD(SO, 1); if constexpr (SD == 2) { if (2 < NT) SLOAD(SE, 2); }
    SWAIT(); SWRITE(1, SO); __syncthreads();
    for (int j = 1; j + 1 < NT; j += 2) {
        SBAR(); qkt<MODE>(pB0, pB1, K_lds + SHM_K, KR_lds + SHM_KR, qr, qrl, r32, hi);
        finishSM(pA0, pA1, alA, l_reg, pa0, pa1, pa2, pa3); SBAR();
        SLOAD(SO, j + SD); SBAR();
        pv_d0(o, vb0, pa0, pa1, pa2, pa3); MASK(pB0, pB1, j); partialSM<MODE>(pB0, pB1, m_reg, mnB, alB);
        __syncthreads(); SWAIT(); SWRITE(0, SE);
        RESC(alB); __syncthreads();
        SBAR(); qkt<MODE>(pA0, pA1, K_lds, KR_lds, qr, qrl, r32, hi);
        finishSM(pB0, pB1, alB, l_reg, pa0, pa1, pa2, pa3); SBAR();
        if (SD == 1 || j + 3 < NT) SLOAD(SE, j + 1 + SD); SBAR();
        pv_d0(o, vb0 + SHM_V, pa0, pa1, pa2, pa3); MASK(pA0, pA1, j + 1); partialSM<MODE>(pA0, pA1, m_reg, mnA, alA);
        __syncthreads(); SWAIT(); SWRITE(1, SO);
        RESC(alA); __syncthreads();
    }
    SBAR(); qkt<MODE>(pB0, pB1, K_lds + SHM_K, KR_lds + SHM_KR, qr, qrl, r32, hi);
    finishSM(pA0, pA1, alA, l_reg, pa0, pa1, pa2, pa3); SBAR();
    pv_d0(o, vb0, pa0, pa1, pa2, pa3); MASK(pB0, pB1, NT - 1); partialSM<MODE>(pB0, pB1, m_reg, mnB, alB);
    __syncthreads(); RESC(alB);
    finishSM(pB0, pB1, alB, l_reg, pa0, pa1, pa2, pa3); SBAR();
    pv_d0(o, vb0 + SHM_V, pa0, pa1, pa2, pa3);
    if (hi == 0) li_l[r32] = l_reg; asm volatile("s_waitcnt lgkmcnt(0)" ::: "memory");
    float rli[16];
#pragma unroll
    for (int r = 0; r < 16; ++r) rli[r] = __builtin_amdgcn_rcpf(li_l[crow(r, hi)]);
    if constexpr (OUTF32) {
        float* Ow = (float*)u.O + (size_t)(wid * QBLK) * u.ldo;
#pragma unroll
        for (int r = 0; r < 16; ++r) { const int orow = crow(r, hi);
#pragma unroll
            for (int d0 = 0; d0 < 4; ++d0) Ow[(size_t)orow * u.ldo + d0 * 32 + r32] = o[d0][r] * rli[r]; }
    } else {
        bf16_t* Ow = (bf16_t*)u.O + (size_t)(wid * QBLK) * u.ldo;
#pragma unroll
        for (int r = 0; r < 16; ++r) { const int orow = crow(r, hi);
#pragma unroll
            for (int d0 = 0; d0 < 4; ++d0) Ow[(size_t)orow * u.ldo + d0 * 32 + r32] = (bf16_t)f2bf(o[d0][r] * rli[r]); }
    }
    __syncthreads();
#undef TROW
#undef SLOAD
#undef SWRITE
#undef SWAIT
#undef RESC
#undef MASK
}
}

constexpr int LDS_BYTES = 147456;

__device__ __forceinline__ int ein_rowmap(int col) {
    if (col < 3072 || col >= 5120) return col;
    const int ld = col & 127, blk = ld >> 6, r = ld & 63, n = r >> 5, r2 = r & 31;
    return (col & ~127) + 32 * (2 * blk + (r2 >> 4)) + 8 * ((r2 >> 2) & 3) + 4 * n + (r2 & 3);
}
__device__ __forceinline__ int uq_rowmap(int c) {
    const int h = c / 192, r = c - h * 192;
    if (r < 128) return h * 128 + r;
    const int rr = r - 128, ld = rr & 31;
    return 2048 + h * 64 + (rr & 32) + 8 * ((ld >> 2) & 3) + 4 * (ld >> 4) + (ld & 3);
}
__device__ __forceinline__ int down_rowmap(int c) {
    if (c < 1024) return c;
    const int rr = c - 1024, ld = rr & 31;
    return 1024 + (rr & 32) + 8 * ((ld >> 2) & 3) + 4 * (ld >> 4) + (ld & 3);
}
__device__ __forceinline__ void transpose_item(const float* W, int K, int N, bf16_t* WT, int drow0, int k0, int n0, LAS float* scr, int lane, int rmap) {
    typedef float f32x2 __attribute__((ext_vector_type(2)));
    const float* src = W + (size_t)(k0 + (lane >> 5)) * N + n0 + 2 * (lane & 31); LAS float* dsts = scr + (lane >> 5) * 66 + 2 * (lane & 31);
#pragma unroll 16
    for (int i = 0; i < 32; ++i) *(LAS f32x2*)(dsts + i * 132) = *(const f32x2*)(src + (size_t)(2 * i) * N);
    asm volatile("s_waitcnt lgkmcnt(0)" ::: "memory");
    const int c = lane & 7;
#pragma unroll
    for (int j = 0; j < 8; ++j) { const int n = (lane >> 3) + 8 * j; const LAS float* s = scr + (8 * c) * 66 + n;
        u32x4 o; o.x = pk2(s[0 * 66], s[1 * 66]); o.y = pk2(s[2 * 66], s[3 * 66]); o.z = pk2(s[4 * 66], s[5 * 66]); o.w = pk2(s[6 * 66], s[7 * 66]);
        *(u32x4*)(WT + (size_t)(rmap == 1 ? ein_rowmap(drow0 + n) : rmap == 2 ? uq_rowmap(drow0 + n) : rmap == 3 ? down_rowmap(drow0 + n) : drow0 + n) * K + k0 + 8 * c) = o; }
    asm volatile("s_waitcnt lgkmcnt(0)" ::: "memory");
}
__device__ __forceinline__ int ffn_rowmap(int n) { return n < DFF ? (n >> 7) * 256 + (n & 127) : ((n - DFF) >> 7) * 256 + 128 + ((n - DFF) & 127); }

__device__ __forceinline__ void phase_prologue(KPP p, unsigned char* lds) {
    const int tid = otid(), lane = tid & 63, wave = tid >> 6;
    const int gw = obid() * 8 + wave, NGW = gridDim.x * 8;
    unsigned char* ws = p->ws;
    if (obid() == 0) {
        { float* gn = (float*)(ws + WS_GAINS); if (tid < 128) { gn[tid] = p->in[13][tid]; gn[128 + tid] = p->in[14][tid]; gn[256 + tid] = p->in[16][tid]; gn[384 + tid] = p->in[17][tid]; } }
        float2* t128 = (float2*)(ws + WS_TAB128); float2* t64 = (float2*)(ws + WS_TAB64);
        for (int i = tid; i < 64 * 32; i += 512) { const int pos = i >> 5, f = i & 31; const float fr = __builtin_amdgcn_exp2f(-13.287712379549449f * (float)f * (1.f / 32.f));
            float rv = (float)pos * fr * 0.15915494309189535f; rv -= rintf(rv); t128[i] = make_float2(__builtin_amdgcn_cosf(rv), __builtin_amdgcn_sinf(rv)); }
        for (int i = tid; i < 64 * 16; i += 512) { const int pos = i >> 4, f = i & 15; const float fr = __builtin_amdgcn_exp2f(-13.287712379549449f * (float)f * (1.f / 16.f));
            float rv = (float)pos * fr * 0.15915494309189535f; rv -= rintf(rv); t64[i] = make_float2(__builtin_amdgcn_cosf(rv), __builtin_amdgcn_sinf(rv)); }
    }
    { u32x4* z = (u32x4*)(ws + WS_WDOWN + (size_t)1088 * DM * 2); const int nz = (DOWNP - 1088) * DM * 2 / 16;
      for (int i = obid() * 512 + tid; i < nz; i += gridDim.x * 512) z[i] = (u32x4){0u, 0u, 0u, 0u}; }
    { u32x4* z0 = (u32x4*)(ws + WS_H - 4096); u32x4* z1 = (u32x4*)(ws + WS_H + (size_t)NROW * DM * 2); const int n1 = 384 * 256;
      for (int i = obid() * 512 + tid; i < 256 + n1; i += gridDim.x * 512) { if (i < 256) z0[i] = (u32x4){0u, 0u, 0u, 0u}; else z1[i - 256] = (u32x4){0u, 0u, 0u, 0u}; } }
    float* sl = (float*)(lds + 73728);
    for (int i = tid; i < 5 * DM; i += 512) { const int r = i / DM, k = i % DM; const float v = r < 4 ? p->in[1][r * DM + k] : p->in[3][k]; sl[i] = silu_f(v); }
    __syncthreads();
    for (int it = gw; it < 2 * KSPLIT * 48; it += NGW) {
        const int nb = it % 48, ks = (it / 48) % KSPLIT, l = it / (48 * KSPLIT);
        const float* W = p->in[4] + (size_t)l * DM * MOD6 + (size_t)(ks * 64) * MOD6 + nb * 256 + lane * 4;
        f32x4 acc[5];
#pragma unroll
        for (int r = 0; r < 5; ++r) acc[r] = (f32x4){0.f, 0.f, 0.f, 0.f};
#pragma unroll 8
        for (int k = 0; k < 64; ++k) { const f32x4 w = *(const f32x4*)(W + (size_t)k * MOD6);
#pragma unroll
            for (int r = 0; r < 5; ++r) acc[r] += w * sl[r * DM + ks * 64 + k]; }
        float* dst = (float*)(ws + WS_MODP) + ((size_t)(ks * 2 + l) * 5) * MOD6 + nb * 256 + lane * 4;
#pragma unroll
        for (int r = 0; r < 5; ++r) *(f32x4*)(dst + (size_t)r * MOD6) = acc[r];
    }
    __syncthreads();
    LAS float* scr = (LAS float*)(lds + wave * 16896);
    constexpr int I0 = 32 * 96, I1 = 32 * 32, I2 = 32 * 172, I4 = 86 * 32, I6 = 32 * 17, I7 = 8 * 48, I8 = 8 * 64, I9 = 32 * 32;
    constexpr int NIT = I0 + I1 + 2 * I2 + 2 * I4 + I6 + I7 + I8 + I9;
    for (int it = gw; it < NIT; it += NGW) {
        int r = it; const float* W; int K, N; bf16_t* WT; bool fmap = false; int emap = 0;
        if (r < I0) { W = p->in[11]; K = DM; N = EPROJ; WT = (bf16_t*)(ws + WS_WEIN); emap = 1; }
        else if ((r -= I0) < I1) { W = p->in[12]; K = DM; N = DM; WT = (bf16_t*)(ws + WS_WEOUT); }
        else if ((r -= I1) < 2 * I2) { const int l = r / I2; r -= l * I2; W = p->in[8] + (size_t)l * DM * DFF2; K = DM; N = DFF2; WT = (bf16_t*)(ws + WS_WFIN + l * WFIN_STRIDE); fmap = true; }
        else if ((r -= 2 * I2) < 2 * I4) { const int l = r / I4; r -= l * I4; W = p->in[10] + (size_t)l * DFF * DM; K = DFF; N = DM; WT = (bf16_t*)(ws + WS_WFOUT + l * WFOUT_STRIDE); }
        else if ((r -= 2 * I4) < I6) { W = p->in[20]; K = DM; N = 1088; WT = (bf16_t*)(ws + WS_WDOWN); emap = 3; }
        else if ((r -= I6) < I7) { W = p->in[23]; K = 512; N = QW; WT = (bf16_t*)(ws + WS_WUQ); emap = 2; }
        else if ((r -= I7) < I8) { W = p->in[24]; K = 512; N = KVW; WT = (bf16_t*)(ws + WS_WUKV); }
        else { r -= I8; W = p->in[29]; K = DM; N = DM; WT = (bf16_t*)(ws + WS_WMOUT); }
        const int nkb = K / 64, kb = r % nkb, nbi = r / nkb, n0 = nbi * 64;
        transpose_item(W, K, N, WT, fmap ? ffn_rowmap(n0) : n0, kb * 64, n0, scr, lane, emap);
    }
}

__device__ __forceinline__ void phase_adared(KPP p) {
    const float* mp = (const float*)(p->ws + WS_MODP); float* mod = (float*)(p->ws + WS_MOD);
    for (int i = obid() * 512 + otid(); i < 2 * 5 * MOD6; i += gridDim.x * 512) {
        const int n = i % MOD6, l = i / (5 * MOD6);
        float s = p->in[5][l * MOD6 + n];
        for (int ks = 0; ks < KSPLIT; ++ks) s += mp[(size_t)ks * (2 * 5 * MOD6) + i];
        mod[i] = s;
    }
}

__device__ __forceinline__ void phase_mod(KPP p, const void* src_lat, bool lat16, const float* src_ctx, int nrows, const float* gain, const float* modl, int shift_off, int scale_off, const float* pgate) {
    const int tid_ = otid(); const int lane = tid_ & 63, gw = obid() * 8 + (tid_ >> 6), NGW = gridDim.x * 8;
    bf16_t* H = (bf16_t*)(p->ws + WS_H);
    for (int row = gw; row < nrows; row += NGW) {
        const bool isctx = row >= NLAT; const int mr = isctx ? 4 : row / SEQ;
        const float* xr = isctx ? src_ctx + (size_t)(row - NLAT) * DM : (const float*)src_lat + (size_t)row * DM;
        const float* sh = modl + (size_t)mr * MOD6 + shift_off; const float* sc = modl + (size_t)mr * MOD6 + scale_off;
        f32x4 v[8]; float ss = 0.f;
        if (!isctx && lat16) { const bf16_t* xb = (const bf16_t*)src_lat + (size_t)row * DM;
#pragma unroll
            for (int j = 0; j < 8; ++j) { const u32x2 w = *(const u32x2*)(xb + j * 256 + lane * 4); v[j] = (f32x4){bflo(w.x), bfhi(w.x), bflo(w.y), bfhi(w.y)}; } }
        else {
#pragma unroll
            for (int j = 0; j < 8; ++j) v[j] = *(const f32x4*)(xr + j * 256 + lane * 4); }
        if (isctx && pgate) {
            const float* pp = (const float*)(p->ws + WS_PART) + (size_t)(row - NLAT) * DM; float* xo = (float*)(p->ws + WS_XC) + (size_t)(row - NLAT) * DM;
#pragma unroll
            for (int j = 0; j < 8; ++j) { const int c = j * 256 + lane * 4; f32x4 a = *(const f32x4*)(pp + c);
#pragma unroll
                for (int k = 1; k < 8; ++k) a += *(const f32x4*)(pp + (size_t)k * NCTX * DM + c);
                v[j] += *(const f32x4*)(pgate + c) * a; *(f32x4*)(xo + c) = v[j]; }
        }
#pragma unroll
        for (int j = 0; j < 8; ++j) ss += (v[j].x * v[j].x + v[j].y * v[j].y) + (v[j].z * v[j].z + v[j].w * v[j].w);
        const float rstd = rsqrtf(wave_sum(ss) * (1.f / DM) + EPS);
#pragma unroll
        for (int j = 0; j < 8; ++j) { const int c = j * 256 + lane * 4; const f32x4 g = *(const f32x4*)(gain + c), s1 = *(const f32x4*)(sc + c), s0 = *(const f32x4*)(sh + c);
            const f32x4 y = (v[j] * rstd * g) * (s1 + 1.f) + s0;
            u32x2 w; w.x = pk2(y.x, y.y); w.y = pk2(y.z, y.w); *(u32x2*)(H + (size_t)row * DM + c) = w; }
    }
}

__device__ __forceinline__ void phase_diffcomb(KPP p) {
    const int tid_ = otid(); const int lane = tid_ & 63, gw = obid() * 8 + (tid_ >> 6), NGW = gridDim.x * 8;
    const float* dl = p->in[18];
    float a = dl[lane] * dl[128 + lane] + dl[64 + lane] * dl[192 + lane], b = dl[256 + lane] * dl[384 + lane] + dl[320 + lane] * dl[448 + lane];
    const float lam_init = 0.2f;
    const float lam = __expf(wave_sum(a)) - __expf(wave_sum(b)) + lam_init;
    const bf16_t* P1 = (const bf16_t*)(p->ws + WS_DIFFP); const bf16_t* P2 = P1 + (size_t)NROW * 1024; bf16_t* O = (bf16_t*)(p->ws + WS_O);
    const float* sg = p->in[19] + (lane & 31) * 8;
    for (int it = gw; it < NROW * 2; it += NGW) {
        const int row = it >> 1, col = (it & 1) * 512 + lane * 8;
        float av[8], bv[8]; unpack8(*(const u32x4*)(P1 + (size_t)row * 1024 + col), av); unpack8(*(const u32x4*)(P2 + (size_t)row * 1024 + col), bv);
        const f32x4 d0 = (f32x4){av[0], av[1], av[2], av[3]} - (f32x4){bv[0], bv[1], bv[2], bv[3]} * lam, d1 = (f32x4){av[4], av[5], av[6], av[7]} - (f32x4){bv[4], bv[5], bv[6], bv[7]} * lam;
        float x[8] = {d0.x, d0.y, d0.z, d0.w, d1.x, d1.y, d1.z, d1.w}; float ss = 0.f;
#pragma unroll
        for (int e = 0; e < 8; ++e) ss += x[e] * x[e];
        const float rstd = rsqrtf(grp_sum<32>(ss) * (1.f / 256.f) + EPS) * (1.f - lam_init);
#pragma unroll
        for (int e = 0; e < 8; ++e) x[e] = x[e] * rstd * sg[e];
        *(u32x4*)(O + (size_t)row * DM + 1024 + col) = pack8(x);
    }
}

__device__ __forceinline__ void phase_att0(KPP p, char* lds) {
    const bf16_t* QKV = (const bf16_t*)(p->ws + WS_QKV); bf16_t* O = (bf16_t*)(p->ws + WS_O); bf16_t* DP = (bf16_t*)(p->ws + WS_DIFFP); const bf16_t* SL = (const bf16_t*)(p->ws + WS_SLAB); constexpr size_t SLS = (size_t)NROW * 128;
    constexpr int NU_DIFF = NB * 4 * 2 * 2 * 16, NU_NA = NB * 8 * 16, NU_CNA = NB * 8, NU_CDIFF = NB * 4 * 2 * 2;
    const int bx_ = obid(), vcu = (gridDim.x % 8 == 0) ? (bx_ % 8) * (gridDim.x / 8) + bx_ / 8 : bx_;
    for (int ui = vcu; ui < NU_DIFF + NU_NA + NU_CNA + NU_CDIFF; ui += gridDim.x) {
        att::AUnit u; u.ldq = EPROJ; u.ldk = 128; u.KR = nullptr; u.qrow0 = 0; u.krow0 = 0; u.qroff = 0;
        if (ui < NU_DIFF || ui >= NU_DIFF + NU_NA + NU_CNA) {
            const bool cx = ui >= NU_DIFF; const int v = cx ? ui - (NU_DIFF + NU_NA + NU_CNA) : ui;
            const int qb = cx ? 0 : (v & 15), rest = cx ? v : (v >> 4), vh = rest & 1, half = (rest >> 1) & 1, h = (rest >> 2) & 3, b = rest >> 4;
            const int qrow = cx ? NLAT + b * CTXL : b * SEQ + qb * 256;
            u.Q = QKV + (size_t)qrow * EPROJ + 3072 + (2 * h + half) * 128;
            u.K = SL + (16 + 2 * h + half) * SLS; u.V = SL + (24 + 2 * h + vh) * SLS;
            if (cx) { u.base0 = NLAT + b * CTXL; u.n0 = 4; u.base1 = 0; u.NT = 4; } else { u.base0 = b * SEQ; u.n0 = 64; u.base1 = NLAT + b * CTXL; u.NT = 68; }
            u.O = DP + (size_t)half * NROW * 1024 + (size_t)qrow * 1024 + h * 256 + vh * 128; u.ldo = 1024;
            att::attn_unit<0, false>(u, lds);
        } else if (ui < NU_DIFF + NU_NA) {
            const int v = ui - NU_DIFF, qb = v & 15, h = (v >> 4) & 7, b = v >> 7;
            const int qrow = b * SEQ + qb * 256, r0 = qb * 4, lo = min(max(r0 - 4, 0), 52);
            {
                float* tab = (float*)(lds + att::OFF_TAB); const float* rp = p->in[15] + h * 465;
                for (int i = otid(); i < 465; i += 512) tab[i] = rp[i] * 11.313708498984761f;
            }
            u.Q = QKV + (size_t)qrow * EPROJ + h * 128; u.K = SL + (size_t)h * SLS; u.V = SL + (size_t)(8 + h) * SLS;
            u.base0 = b * SEQ + lo * 64; u.n0 = 12; u.base1 = NLAT + b * CTXL; u.NT = 16; u.qrow0 = r0; u.krow0 = lo;
            u.O = O + (size_t)qrow * DM + h * 128; u.ldo = DM;
            att::attn_unit<1, false>(u, lds);
        } else {
            const int v = ui - NU_DIFF - NU_NA, h = v & 7, b = v >> 3; const int qrow = NLAT + b * CTXL;
            u.Q = QKV + (size_t)qrow * EPROJ + h * 128; u.K = SL + (size_t)h * SLS; u.V = SL + (size_t)(8 + h) * SLS;
            u.base0 = qrow; u.n0 = 4; u.base1 = 0; u.NT = 4;
            u.O = O + (size_t)qrow * DM + h * 128; u.ldo = DM;
            att::attn_unit<0, false>(u, lds);
        }
    }
}
__device__ __forceinline__ void phase_att1(KPP p, char* lds) {
    const bf16_t* Q1 = (const bf16_t*)(p->ws + WS_Q1); const bf16_t* KV1 = (const bf16_t*)(p->ws + WS_KV1); bf16_t* O = (bf16_t*)(p->ws + WS_O1);
    const int bx_ = obid(), vcu = (gridDim.x % 8 == 0) ? (bx_ % 8) * (gridDim.x / 8) + bx_ / 8 : bx_;
    for (int ui = vcu; ui < NB * 16 * 16; ui += gridDim.x) {
        const int qb = ui & 15, h = (ui >> 4) & 15, b = ui >> 8; const int qrow = b * SEQ + qb * 256;
        att::AUnit u; u.ldq = QW; u.ldk = KVW; u.KR = (const bf16_t*)(p->ws + WS_KROPE); u.qrow0 = 0; u.krow0 = 0;
        u.Q = Q1 + (size_t)qrow * QW + h * 128; u.qroff = 2048 - h * 64; u.K = KV1 + h * 256; u.V = KV1 + h * 256 + 128;
        u.base0 = b * SEQ; u.n0 = 64; u.base1 = NLAT + b * CTXL; u.NT = 68;
        u.O = O + (size_t)qrow * DM + h * 128; u.ldo = DM;
        att::attn_unit<2, false>(u, lds);
    }
}

#define XB_TMO      128
#define XB_XCNT(j)  (256  + 64 * (j))
#define XB_XSUB(j)  (1280 + 64 * (j))
#define XB_XGEN(j)  (2304 + 64 * (j))
#define XB_TOP      3328
#define XB_TOPGEN   3392
#define XCD_BAR_WORDS 3456
#define XB_SPIN_CAP (1u << 18)

__device__ __forceinline__ unsigned xb_ld(unsigned* p)              { return __hip_atomic_load(p, __ATOMIC_RELAXED, __HIP_MEMORY_SCOPE_AGENT); }
__device__ __forceinline__ unsigned xb_add(unsigned* p, unsigned v) { return __hip_atomic_fetch_add(p, v, __ATOMIC_RELAXED, __HIP_MEMORY_SCOPE_AGENT); }
__device__ __forceinline__ unsigned xb_xcc_id() { return (unsigned)__builtin_amdgcn_s_getreg((3 << 11) | 20) & 0xFu; }
#define XB_SPIN(cond, bar) do { unsigned _sp = 0; while (cond) { __builtin_amdgcn_s_sleep(1); \
    if ((++_sp & 255u) == 0u) { if (xb_ld(&(bar)[XB_TMO])) break; if (_sp > XB_SPIN_CAP) { atomicAdd(&(bar)[XB_TMO], 1u); break; } } } } while (0)

struct XcdBarrier {
    unsigned* bar; unsigned x;
    volatile LAS unsigned* st;
};

__device__ __forceinline__ XcdBarrier xcd_barrier_post(unsigned* bar, volatile LAS unsigned* st) {
    XcdBarrier b; b.bar = bar; b.x = xb_xcc_id(); b.st = st;
    if (threadIdx.x == 0) (void)xb_add(&bar[XB_XCNT(b.x)], 1u);
    return b;
}
__device__ __forceinline__ void xcd_barrier_complete(unsigned* bar, unsigned x, unsigned& nloc, unsigned& nx) {
    const unsigned G = gridDim.x * gridDim.y * gridDim.z;
    unsigned sum, cnt, mine, sp = 0u;
    for (;;) {
        sum = 0u; cnt = 0u; mine = 0u;
#pragma unroll
        for (unsigned j = 0; j < 16; ++j) { const unsigned c = xb_ld(&bar[XB_XCNT(j)]); sum += c; cnt += (c > 0u) ? 1u : 0u; mine = (j == x) ? c : mine; }
        if (sum == G) break;
        __builtin_amdgcn_s_sleep(1);
        if ((++sp & 255u) == 0u) { if (xb_ld(&bar[XB_TMO])) break; if (sp > XB_SPIN_CAP) { atomicAdd(&bar[XB_TMO], 1u); break; } }
    }
    nloc = mine > 0u ? mine : 1u; nx = cnt > 0u ? cnt : 1u;
}

__device__ __forceinline__ void xcd_barrier(const XcdBarrier& b) {
    asm volatile("s_waitcnt vmcnt(0)" ::: "memory");
    __syncthreads();
    if (threadIdx.x == 0) {
        unsigned* bar = b.bar;
        __builtin_amdgcn_s_waitcnt(0);
        unsigned nloc = b.st[0], nx = b.st[1];
        if (nloc == 0u) { xcd_barrier_complete(bar, b.x, nloc, nx); b.st[0] = nloc; b.st[1] = nx; }
        const unsigned old = xb_add(&bar[XB_XSUB(b.x)], 1u);
        const unsigned gen = old / nloc;
        if (old + 1u == (gen + 1u) * nloc) {
            __builtin_amdgcn_fence(__ATOMIC_RELEASE, "agent");
            asm volatile("s_waitcnt vmcnt(0)" ::: "memory");
            const unsigned og = xb_add(&bar[XB_TOP], 1u);
            const unsigned tg = og / nx;
            if (og + 1u == (tg + 1u) * nx) xb_add(&bar[XB_TOPGEN], 1u);
            else XB_SPIN(xb_ld(&bar[XB_TOPGEN]) == tg, bar);
            __builtin_amdgcn_fence(__ATOMIC_ACQUIRE, "agent");
            xb_add(&bar[XB_XGEN(b.x)], 1u);
            asm volatile("s_waitcnt vmcnt(0)" ::: "memory");
        } else {
            XB_SPIN(xb_ld(&bar[XB_XGEN(b.x)]) == gen, bar);
            __builtin_amdgcn_fence(__ATOMIC_ACQUIRE, "agent");
            asm volatile("s_waitcnt vmcnt(0)" ::: "memory");
        }
    }
    __syncthreads();
}

enum { K_PRO, K_ADARED, K_MOD, K_GEMM_BF16, K_GEMM_F32, K_GEMM_RES, K_QKNORM, K_ATT0, K_DIFFCOMB, K_CONV, K_POSTDOWN, K_POSTUP, K_ATT1, K_GEMM_CONV, K_GEMM_QK, K_GEMM_Q1, K_GEMM_KV, K_GEMM_DOWN };
constexpr int NPH = 19;

__global__ void __launch_bounds__(512, 2) mk_fwd(KP p_unused) {
    extern __shared__ __attribute__((aligned(16))) unsigned char lds[];
    const int G = gridDim.x;
    volatile LAS unsigned* bst = (volatile LAS unsigned*)((LAS unsigned char*)lds + (LDS_BYTES - 256));
    if (threadIdx.x < 4) bst[threadIdx.x] = 0u;
    __syncthreads();
    XcdBarrier gbar; gbar.bar = nullptr; gbar.x = 0; gbar.st = nullptr;
#if ONE_LAUNCH
    gbar = xcd_barrier_post((unsigned*)(((KPP)__builtin_amdgcn_kernarg_segment_ptr())->ws), bst);
#endif
    const int ph_lo = ((KPP)__builtin_amdgcn_kernarg_segment_ptr())->ph_lo, ph_hi = ((KPP)__builtin_amdgcn_kernarg_segment_ptr())->ph_hi;
    for (int ph = ph_lo; ph < ph_hi; ++ph) {
        KPP p = (KPP)__builtin_amdgcn_kernarg_segment_ptr(); asm volatile("" : "+s"(p));
        unsigned char* ws = p->ws;
        float* XC = (float*)(ws + WS_XC); const float* MOD = (const float*)(ws + WS_MOD);
        const bf16_t* H = (const bf16_t*)(ws + WS_H);
        int kind = K_PRO, layer = ph >= 10 ? 1 : 0; bool nosync = false;
        const bf16_t* gA = H; const bf16_t* gB = nullptr; int gM = NROW, gN = 0, gK = DM; void* gO = nullptr; int gld = 0;
        const void* rs_lat = ws + WS_XB; void* rd_lat = ws + WS_XB; bool rs16 = true, rd16 = true; const float* rs_ctx = XC; int gate_off = 0;
        const void* m_lat = ws + WS_XB; bool m16 = true; const float* m_ctx = XC; int m_rows = NROW; const float* m_gain = nullptr; int m_sh = 0, m_sc = 0; const float* m_pg = nullptr;
        switch (ph) {
            case 0: kind = K_PRO; break;
            case 1: kind = K_ADARED; break;
            case 2: kind = K_MOD; m_lat = p->in[0]; m16 = false; m_ctx = p->in[2]; m_gain = p->in[6]; m_sh = 0; m_sc = 2048; break;
            case 3: kind = K_GEMM_QK; gB = (const bf16_t*)(ws + WS_WEIN); gN = EPROJ; break;
            case 4: kind = K_ATT0; break;
            case 5: kind = K_DIFFCOMB; break;
            case 6: kind = K_GEMM_RES; gA = (const bf16_t*)(ws + WS_O); gB = (const bf16_t*)(ws + WS_WEOUT); gN = DM; rs_lat = p->in[0]; rs16 = false; rs_ctx = p->in[2]; gate_off = 4096; break;
            case 7: kind = K_MOD; m_gain = p->in[7]; m_sh = 6144; m_sc = 8192; m_ctx = p->in[2]; m_pg = MOD + 4 * MOD6 + 4096; break;
            case 8: case 17: kind = K_GEMM_CONV; gB = (const bf16_t*)(ws + WS_WFIN + layer * WFIN_STRIDE); gM = layer ? NLAT : NROW; break;
            case 9: case 18: kind = K_GEMM_RES; gA = (const bf16_t*)(ws + WS_ACT); gB = (const bf16_t*)(ws + WS_WFOUT + layer * WFOUT_STRIDE); gN = DM; gK = DFF; gate_off = 10240; gM = layer ? NLAT : NROW; if (layer) { rd_lat = p->out; rd16 = false; } break;
            case 10: kind = K_MOD; m_gain = p->in[6] + DM; m_sh = 0; m_sc = 2048; m_pg = MOD + 4 * MOD6 + 10240; break;
            case 11: kind = K_GEMM_DOWN; gB = (const bf16_t*)(ws + WS_WDOWN); gN = DOWNP; break;
            case 12: kind = K_GEMM_Q1; gA = (const bf16_t*)(ws + WS_QLAT); gB = (const bf16_t*)(ws + WS_WUQ); gM = NLAT; gN = QW; gK = 512; nosync = true; break;
            case 13: kind = K_GEMM_KV; gA = (const bf16_t*)(ws + WS_KVLAT); gB = (const bf16_t*)(ws + WS_WUKV); gN = KVW; gK = 512; break;
            case 14: kind = K_ATT1; break;
            case 15: kind = K_GEMM_RES; gA = (const bf16_t*)(ws + WS_O1); gB = (const bf16_t*)(ws + WS_WMOUT); gM = NLAT; gN = DM; gate_off = 4096; break;
            case 16: kind = K_MOD; m_rows = NLAT; m_gain = p->in[7] + DM; m_sh = 6144; m_sc = 8192; break;
            default: break;
        }
        const float* modl = MOD + (size_t)layer * 5 * MOD6;
        int rep = 1;
#if PROBE & 1
        if (kind == K_ATT0 || kind == K_ATT1) rep = 2;
#endif
#if PROBE & 2
        if (kind == K_GEMM_BF16 || kind == K_GEMM_DOWN || kind == K_GEMM_CONV || kind == K_GEMM_QK || kind == K_GEMM_Q1 || kind == K_GEMM_KV) rep = 2;
#endif
#if PROBE & 4
        if (kind == K_PRO) rep = 2;
#endif
#if PROBE & 8
        if (kind == K_MOD || kind == K_DIFFCOMB) rep = 2;
#endif
        for (int rp = 0; rp < rep; ++rp) {
        if (rp) xcd_barrier(gbar);
        switch (kind) {
            case K_PRO:
#ifndef DIS_PRO
 phase_prologue(p, lds);
#endif
 break;
            case K_ADARED: phase_adared(p); break;
            case K_MOD: phase_mod(p, m_lat, m16, m_ctx, m_rows, m_gain, modl, m_sh, m_sc, m_pg); break;
            #ifndef DIS_GEMM
            case K_GEMM_BF16: { pg8::Gemm g{gA, gB, gM, gN, gK}; pg8::StaticOrder S; S.init(gM, gN, G, obid());
                pg8::EpiBf16<0> E{(bf16_t*)gO, gld, nullptr, 0, 0, 1.f};
                pg8::gemm_phase<pg8::EpiBf16<0>, pg8::StaticOrder, true, true>((PG8_LAS unsigned char*)lds, g, S, E); } break;
            case K_GEMM_CONV: { const int ntm = (gM + 253) / 254; pg8::Gemm g{H - DM, gB, ntm * 256, DFF2, DM, 254}; pg8::StaticOrder S; S.init(ntm * 256, DFF2, G, obid());
                EpiConv E{(bf16_t*)(ws + WS_ACT), p->in[9] + (size_t)layer * 3 * DFF2, gM, (LAS float*)((LAS unsigned char*)lds + 131072)};
                pg8::gemm_phase<EpiConv, pg8::StaticOrder, true, true>((PG8_LAS unsigned char*)lds, g, S, E); } break;
            case K_GEMM_QK: { pg8::Gemm g{gA, gB, gM, gN, gK}; pg8::StaticOrder S; S.init(gM, gN, G, obid());
                EpiQK E{(bf16_t*)(ws + WS_QKV), (const float*)(ws + WS_GAINS), (LAS float*)((LAS unsigned char*)lds + 131072), (bf16_t*)(ws + WS_SLAB)};
                pg8::gemm_phase<EpiQK, pg8::StaticOrder, true, true>((PG8_LAS unsigned char*)lds, g, S, E); } break;
            case K_GEMM_Q1: { pg8::Gemm g{gA, gB, gM, gN, gK}; pg8::StaticOrder S; S.init(gM, gN, G, obid());
                EpiQ1 E{(bf16_t*)(ws + WS_Q1), p->in[25], p->in[26], (LAS float*)((LAS unsigned char*)lds + 131072), (const float*)(ws + WS_SSQ)};
                pg8::gemm_phase<EpiQ1, pg8::StaticOrder, true, true>((PG8_LAS unsigned char*)lds, g, S, E); } break;
            case K_GEMM_KV: { pg8::Gemm g{gA, gB, gM, gN, gK}; pg8::StaticOrder S; S.init(gM, gN, G, obid());
                EpiKV E{(bf16_t*)(ws + WS_KV1), p->in[27], (LAS float*)((LAS unsigned char*)lds + 131072), (const float*)(ws + WS_SSKV)};
                pg8::gemm_phase<EpiKV, pg8::StaticOrder, true, true>((PG8_LAS unsigned char*)lds, g, S, E); } break;
            case K_GEMM_DOWN: { pg8::Gemm g{gA, gB, gM, gN, gK}; pg8::StaticOrder S; S.init(gM, gN, G, obid());
                EpiDown E{(bf16_t*)(ws + WS_QLAT), (bf16_t*)(ws + WS_KVLAT), (bf16_t*)(ws + WS_KROPE), (float*)(ws + WS_SSKV), (float*)(ws + WS_SSQ), p->in[21], p->in[22], p->in[28], (LAS float*)((LAS unsigned char*)lds + 131072)};
                pg8::gemm_phase<EpiDown, pg8::StaticOrder, true, true>((PG8_LAS unsigned char*)lds, g, S, E); } break;
            case K_GEMM_RES: { pg8::Gemm g{gA, gB, gM, gN, gK}; SplitOrder S; S.init(gN, gK, G, obid(), gM > NLAT);
                EpiRes E{rs_lat, rd_lat, modl, gate_off, (float*)(ws + WS_PART), rs16, rd16};
                pg8::gemm_phase<EpiRes, SplitOrder, true, true>((PG8_LAS unsigned char*)lds, g, S, E); } break;
#endif
            case K_ATT0:
#ifndef DIS_ATT0
 phase_att0(p, (char*)lds);
#endif
 break;
            case K_DIFFCOMB:
#ifndef DIS_EW
 phase_diffcomb(p);
#endif
 break;
            case K_ATT1:
#ifndef DIS_ATT1
 phase_att1(p, (char*)lds);
#endif
 break;
        }
        }
#if PROBE & 16
        if (ph + 1 < ph_hi) xcd_barrier(gbar);
#endif
        if (ph + 1 < ph_hi) { if (nosync) __syncthreads(); else if (ph_hi > 4096) cg::this_grid().sync(); else xcd_barrier(gbar); }
    }
}

extern "C" void kernel_launch(void* const* d_in, const int* in_sizes, int n_in, void* d_out, int out_size, void* d_ws, size_t ws_size, hipStream_t stream) {
    static int grid = 0;
    if (grid == 0) {
        if (n_in != 30 || ws_size < WS_END) { fprintf(stderr, "kernel_launch: n_in %d ws %zu (need %zu)\n", n_in, ws_size, (size_t)WS_END); grid = -1; return; }
        int dev = 0, cus = 0, per_cu = 0;
        hipGetDevice(&dev); hipDeviceGetAttribute(&cus, hipDeviceAttributeMultiprocessorCount, dev);
        hipFuncSetAttribute((const void*)mk_fwd, hipFuncAttributeMaxDynamicSharedMemorySize, LDS_BYTES);
        hipOccupancyMaxActiveBlocksPerMultiprocessor(&per_cu, (const void*)mk_fwd, 512, LDS_BYTES);
        (void)hipGetLastError();
        if (per_cu < 1) per_cu = 1;
        grid = cus;
    }
    if (grid < 0) return;
    hipMemsetAsync(d_ws, 0, 16384, stream);
    KP a{};
    for (int i = 0; i < 30; ++i) a.in[i] = (const float*)d_in[i];
    a.out = (float*)d_out; a.ws = (unsigned char*)d_ws;
#if ONE_LAUNCH
    a.ph_lo = 0; a.ph_hi = NPH;
    void* args[] = {&a};
    hipError_t e = hipLaunchCooperativeKernel((const void*)mk_fwd, dim3(grid), dim3(512), args, LDS_BYTES, stream);
    if (e != hipSuccess) fprintf(stderr, "cooperative launch failed: %s (grid %d)\n", hipGetErrorString(e), grid);
#else
    for (int ph = 0; ph < NPH; ++ph) { a.ph_lo = ph; a.ph_hi = ph + 1; hipLaunchKernelGGL(mk_fwd, dim3(grid), dim3(512), LDS_BYTES, stream, a); }
#endif
}
```
